# Optimizing an MI355X kernel written in HIP

```python
import math
import jax, jax.numpy as jnp
from jax import lax
import numpy as np

D_MODEL = 2048
BATCH = 1
SEQ = 8192
DEPTH = 1

HEAD_DIM = 128
N_Q_HEADS = 8
N_KV_HEADS = 2
Q_PER_KV = N_Q_HEADS // N_KV_HEADS
Q_BLOCK = 128
GRID_W = 64
ROPE_THETA = 10000.0
ROPE_PAIRS = HEAD_DIM // 4
GMLP_GROUPS = 4
GMLP_GROUP_DIM = 128
GMLP_WIDTH = GMLP_GROUPS * GMLP_GROUP_DIM
CHUNK = 128
MEM_TOKENS = 256
N_MEM_HEADS = 4
MEM_WIDTH = N_MEM_HEADS * HEAD_DIM
N_BRANCHES = 3
D_FF = 4 * D_MODEL
EPS = 1e-6

ATTN_Q_W = N_Q_HEADS * HEAD_DIM
ATTN_KV_W = N_KV_HEADS * HEAD_DIM
SPLITS = [ATTN_Q_W, ATTN_KV_W, ATTN_KV_W, 2 * GMLP_WIDTH, MEM_WIDTH, N_BRANCHES * D_MODEL]
IN_W = sum(SPLITS)
SPLIT_IDX = list(np.cumsum(SPLITS)[:-1].tolist())

kernel_name = "hybrid_gated_attn_gmlp_memxattn_encoder"


def rms_norm(x, g):
    xf = x.astype(jnp.float32)
    y = xf * lax.rsqrt(jnp.mean(xf * xf, axis=-1, keepdims=True) + EPS)
    return (y * g.astype(jnp.float32)).astype(x.dtype)


def axial_rope_tables(S, dtype):
    rows = S // GRID_W
    t_row = jnp.repeat(jnp.arange(rows), GRID_W).astype(jnp.float32)
    t_col = jnp.tile(jnp.arange(GRID_W), rows).astype(jnp.float32)
    inv = ROPE_THETA ** (-jnp.arange(ROPE_PAIRS, dtype=jnp.float32) / ROPE_PAIRS)
    ar = t_row[:, None] * inv
    ac = t_col[:, None] * inv
    ang = jnp.concatenate([ar, ar, ac, ac], axis=-1)
    return jnp.cos(ang).astype(dtype), jnp.sin(ang).astype(dtype)


def apply_axial_rope(x, cos, sin):
    xs = x.reshape(*x.shape[:-1], 2, 2, ROPE_PAIRS)
    rot = jnp.stack([-xs[..., 1, :], xs[..., 0, :]], axis=-2).reshape(x.shape)
    return x * cos[None, :, None, :] + rot * sin[None, :, None, :]


def self_attention(q, k, v):
    B, S = q.shape[0], q.shape[1]
    nb = S // Q_BLOCK
    q = q * jnp.asarray(HEAD_DIM ** -0.5, q.dtype)
    qb = q.reshape(B, nb, Q_BLOCK, N_KV_HEADS, Q_PER_KV, HEAD_DIM).transpose(1, 0, 2, 3, 4, 5)

    def block(qblk):
        s = jnp.einsum('bqgrd,bkgd->bgrqk', qblk, k).astype(jnp.float32)
        p = jax.nn.softmax(s, axis=-1).astype(v.dtype)
        return jnp.einsum('bgrqk,bkgd->bqgrd', p, v)

    o = lax.map(block, qb)
    return o.transpose(1, 0, 2, 3, 4, 5).reshape(B, S, N_Q_HEADS * HEAD_DIM)


def chunked_gmlp(z, sgu_g, w_s, b_s):
    B, S = z.shape[0], z.shape[1]
    u, v = jnp.split(z, 2, axis=-1)
    v = rms_norm(v, sgu_g)
    vc = v.reshape(B, S // CHUNK, CHUNK, GMLP_GROUPS, GMLP_GROUP_DIM)
    mixed = jnp.einsum('gij,bcjgd->bcigd', w_s, vc) + b_s.T[None, None, :, :, None]
    return u * mixed.reshape(B, S, GMLP_WIDTH)


def memory_attention(qm, mem_n, w_mem_kv, mq_g, mk_g):
    B, S = qm.shape[0], qm.shape[1]
    M = mem_n.shape[1]
    km, vm = jnp.split(mem_n @ w_mem_kv, 2, axis=-1)
    qm = rms_norm(qm.reshape(B, S, N_MEM_HEADS, HEAD_DIM), mq_g) * jnp.asarray(HEAD_DIM ** -0.5, qm.dtype)
    km = rms_norm(km.reshape(B, M, N_MEM_HEADS, HEAD_DIM), mk_g)
    vm = vm.reshape(B, M, N_MEM_HEADS, HEAD_DIM)
    s = jnp.einsum('bshd,bmhd->bhsm', qm, km).astype(jnp.float32)
    p = jax.nn.softmax(s, axis=-1).astype(vm.dtype)
    return jnp.einsum('bhsm,bmhd->bshd', p, vm).reshape(B, S, MEM_WIDTH)


def setup_inputs(seed: int = 0) -> dict:
    key = jax.random.key(seed)
    ks = jax.random.split(key, 24)
    f32 = jnp.float32

    def w(k, shape, fan_in, scale=1.0):
        return jax.random.normal(k, shape, f32) * (scale * fan_in ** -0.5)

    def gain(k, shape):
        return 1.0 + 0.02 * jax.random.normal(k, shape, f32)

    L = DEPTH
    return {
        "x": jax.random.normal(ks[0], (BATCH, SEQ, D_MODEL), f32),
        "mem": jax.random.normal(ks[1], (BATCH, MEM_TOKENS, D_MODEL), f32),
        "norm_mix": gain(ks[2], (L, D_MODEL)),
        "w_in": w(ks[3], (L, D_MODEL, IN_W), D_MODEL),
        "q_norm": gain(ks[4], (L, HEAD_DIM)),
        "k_norm": gain(ks[5], (L, HEAD_DIM)),
        "sgu_norm": gain(ks[6], (L, GMLP_WIDTH)),
        "w_spatial": w(ks[7], (L, GMLP_GROUPS, CHUNK, CHUNK), CHUNK),
        "b_spatial": 1.0 + 0.02 * jax.random.normal(ks[8], (L, GMLP_GROUPS, CHUNK), f32),
        "mem_norm": gain(ks[9], (L, D_MODEL)),
        "w_mem_kv": w(ks[10], (L, D_MODEL, 2 * MEM_WIDTH), D_MODEL),
        "mq_norm": gain(ks[11], (L, HEAD_DIM)),
        "mk_norm": gain(ks[12], (L, HEAD_DIM)),
        "w_attn_o": w(ks[13], (L, ATTN_Q_W, D_MODEL), ATTN_Q_W),
        "w_gmlp_o": w(ks[14], (L, GMLP_WIDTH, D_MODEL), GMLP_WIDTH),
        "w_mem_o": w(ks[15], (L, MEM_WIDTH, D_MODEL), MEM_WIDTH),
        "w_out": w(ks[16], (L, D_MODEL, D_MODEL), D_MODEL, 0.5),
        "norm_ffn": gain(ks[17], (L, D_MODEL)),
        "w_ffn_up": w(ks[18], (L, D_MODEL, D_FF), D_MODEL),
        "w_ffn_down": w(ks[19], (L, D_FF, D_MODEL), D_FF, 0.5),
    }


def reference(x, mem, norm_mix, w_in, q_norm, k_norm, sgu_norm, w_spatial, b_spatial,
              mem_norm, w_mem_kv, mq_norm, mk_norm, w_attn_o, w_gmlp_o, w_mem_o, w_out,
              norm_ffn, w_ffn_up, w_ffn_down):
    B, S = x.shape[0], x.shape[1]
    cos, sin = axial_rope_tables(S, x.dtype)
    for l in range(DEPTH):
        h = rms_norm(x, norm_mix[l])
        proj = h @ w_in[l]
        q, k, v, zg, qm, gate_logits = jnp.split(proj, SPLIT_IDX, axis=-1)

        q = apply_axial_rope(rms_norm(q.reshape(B, S, N_Q_HEADS, HEAD_DIM), q_norm[l]), cos, sin)
        k = apply_axial_rope(rms_norm(k.reshape(B, S, N_KV_HEADS, HEAD_DIM), k_norm[l]), cos, sin)
        v = v.reshape(B, S, N_KV_HEADS, HEAD_DIM)
        y_attn = self_attention(q, k, v) @ w_attn_o[l]

        y_gmlp = chunked_gmlp(jax.nn.gelu(zg), sgu_norm[l], w_spatial[l], b_spatial[l]) @ w_gmlp_o[l]

        mem_n = rms_norm(mem, mem_norm[l])
        y_mem = memory_attention(qm, mem_n, w_mem_kv[l], mq_norm[l], mk_norm[l]) @ w_mem_o[l]

        g_a, g_g, g_m = jnp.split(jax.nn.sigmoid(gate_logits), N_BRANCHES, axis=-1)
        merged = g_a * y_attn + g_g * y_gmlp + g_m * y_mem
        x = x + merged @ w_out[l]

        h2 = rms_norm(x, norm_ffn[l])
        x = x + jnp.square(jax.nn.relu(h2 @ w_ffn_up[l])) @ w_ffn_down[l]
    return x
```

```cpp
#include <hip/hip_runtime.h>
#include <hip/hip_cooperative_groups.h>
#include <cstdio>
#include <cstdint>
namespace cg = cooperative_groups;

#define LAS __attribute__((address_space(3)))
typedef unsigned short bf16_t;
typedef short bf16x8 __attribute__((ext_vector_type(8)));
typedef short s16x4 __attribute__((ext_vector_type(4)));
typedef float f32x4 __attribute__((ext_vector_type(4)));
typedef float f32x8 __attribute__((ext_vector_type(8)));
typedef float f32x16 __attribute__((ext_vector_type(16)));
typedef unsigned u32x4 __attribute__((ext_vector_type(4)));
typedef unsigned u32x2 __attribute__((ext_vector_type(2)));

constexpr int S = 8192, DM = 2048, INW = 9216, DFF = 8192, MEMT = 256;
constexpr float EPS = 1e-6f;
constexpr size_t MiB = 1024ull * 1024ull;
constexpr size_t WS_WDOWN = 0 * MiB, WS_WUP = 32 * MiB, WS_WOUT = 64 * MiB, WS_WCAT = 72 * MiB, WS_H = 80 * MiB  ,
                 WS_SMALL = 112 * MiB, WS_R0 = 116 * MiB  , WS_WMKV = 152 * MiB, WS_GATES = 156 * MiB,
                 WS_QMRAW = 252 * MiB, WS_VB = 268 * MiB, WS_UB = 272 * MiB, WS_END = 280 * MiB;
constexpr size_t SM_ROWSS = 0, SM_SSV = 32 * 1024, SM_MEMN = 64 * 1024, SM_KMRAW = SM_MEMN + 1 * MiB, SM_KMB = SM_KMRAW + 512 * 1024, SM_VMB = SM_KMB + 256 * 1024, SM_BAR = 2560 * 1024  , SM_CS = SM_BAR + 64 * 1024  , SM_SSQ = 3072 * 1024  ,
                 SM_ROWSSP = 3584 * 1024  , SM_SSVP = 3840 * 1024  ;
constexpr size_t R0_QB = 0  , R0_KB = 24 * MiB, R0_VN = 28 * MiB;
constexpr int LDS_ST_OFF = 133120, LDS_XCH_OFF = 133136  , LDS_BYTES = 133136 + 8192;

struct Args {
    const float *x, *mem, *norm_mix, *w_in, *q_norm, *k_norm, *sgu_norm, *w_spatial, *b_spatial, *mem_norm, *w_mem_kv, *mq_norm, *mk_norm,
                *w_attn_o, *w_gmlp_o, *w_mem_o, *w_out, *norm_ffn, *w_ffn_up, *w_ffn_down;
    float* out; unsigned char* ws; int ph_lo, ph_hi;
};
typedef __attribute__((address_space(4))) const Args CArgs;
#define ARGP() ({ CArgs* p_ = (CArgs*)__builtin_amdgcn_kernarg_segment_ptr(); asm volatile("" : "+s"(p_)); p_; })

__device__ __forceinline__ unsigned cvt_pk_bf16(float lo, float hi) { unsigned r; asm volatile("v_cvt_pk_bf16_f32 %0, %1, %2" : "=v"(r) : "v"(lo), "v"(hi)); return r; }
__device__ __forceinline__ float wave_sum(float v) {
#pragma unroll
    for (int o = 1; o < 64; o <<= 1) v += __shfl_xor(v, o);
    return v;
}
__device__ __forceinline__ float gelu_tanh(float x) {
    const float e = __builtin_amdgcn_exp2f(x * (-2.302208198f - 0.10294324f * x * x));
    return x * __builtin_amdgcn_rcpf(1.0f + e);
}
__device__ __forceinline__ float sigmoidf_(float z) { return __builtin_amdgcn_rcpf(1.0f + __builtin_amdgcn_exp2f(-1.4426950408889634f * z)); }

namespace pg8 {
constexpr int BM = 256, BK = 64, HALF = 128, HTB = HALF * BK * 2, STAGE_BYTES = 8 * HTB, NXCD = 8, WGM = 8;
__device__ __forceinline__ int lds_byte(int r, int c) { const int st = (r >> 4) * 2 + (c >> 5), rr = r & 15, cc = c & 31, ob = rr * 64 + cc * 2; return st * 1024 + (ob ^ (((ob >> 9) & 1) << 5)); }
__device__ __forceinline__ void stage_rc(int b, int& R, int& C) { const int st = b / 1024, sb = b % 1024, swz = sb ^ (((sb >> 9) & 1) << 5); R = (st >> 1) * 16 + swz / 64; C = (st & 1) * 32 + (swz % 64) / 2; }
__device__ __forceinline__ int perm32(int rho) { const int n = rho >> 4, i = rho & 15; return 8 * (i >> 2) + 4 * n + (i & 3); }

struct Unit { int pm, pn, kb, nt, tag, keep; };
struct Gemm { const bf16_t* A; const bf16_t* Bt; int K; };

__device__ __forceinline__ void map_tile(long L, int nM, int nN, int& pm, int& pn) {
    const int nwg = nM * nN; int wgid = (int)L;
    { const int q = nwg / NXCD, r = nwg % NXCD, xcd = wgid % NXCD, off = wgid / NXCD; wgid = (xcd < r ? xcd * (q + 1) : r * (q + 1) + (xcd - r) * q) + off; }
    const int nig = WGM * nN, gid = wgid / nig, fm = gid * WGM, gsz = (nM - fm) < WGM ? (nM - fm) : WGM;
    pm = fm + ((wgid % nig) % gsz); pn = (wgid % nig) / gsz;
}
struct StaticOrder {
    int nM, nN, nwg, G, c, nt;
    __device__ void init(int M, int N, int K, int G_, int c_) { nM = M / BM; nN = N / BM; nwg = nM * nN; G = G_; c = c_; nt = K / BK; }
    __device__ bool next(int i, Unit& u) const {
        const long L = (long)i * G + c; if (L >= nwg) return false;
        map_tile(L, nM, nN, u.pm, u.pn); u.kb = 0; u.nt = nt; u.tag = 0; u.keep = 0; return true;
    }
};
struct InProjOrder : StaticOrder {
    __device__ bool next(int i, Unit& u) const {
        if (!StaticOrder::next(i, u)) return false;
        const unsigned long long T0 = 0x34c0c11c608014bull, T1 = 0x5d65544d24503ceull, T2 = 0x75c6da288658244ull, T3 = 0x8e28607deull;
        const int k = u.pn / 10, j = u.pn - 10 * k; const unsigned long long t = k == 0 ? T0 : (k == 1 ? T1 : (k == 2 ? T2 : T3));
        u.pn = (int)((t >> (6 * j)) & 63ull); return true;
    }
};
struct BranchOrder {
    int nM, nN, nwg, G, c;
    __device__ void init(int M, int N, int G_, int c_) { nM = M / BM; nN = N / BM; nwg = nM * nN; G = G_; c = c_; }
    __device__ bool next(int i, Unit& u) const {
        const int ti = i / 3, br = i - 3 * ti; const long L = (long)ti * G + c; if (L >= nwg) return false;
        map_tile(L, nM, nN, u.pm, u.pn); u.kb = (br == 0 ? 0 : (br == 1 ? 1024 : 1536)) * 2; u.nt = (br == 0 ? 16 : 8); u.tag = br; u.keep = br < 2; return true;
    }
};

struct ZeroInit { __device__ __forceinline__ void operator()(f32x4 (&acc)[2][2][4][2], const Unit&, int, int, int, int) const {
#pragma unroll
    for (int a = 0; a < 2; ++a)
#pragma unroll
        for (int b = 0; b < 2; ++b)
#pragma unroll
            for (int m = 0; m < 4; ++m)
#pragma unroll
                for (int n = 0; n < 2; ++n) acc[a][b][m][n] = (f32x4){0.f, 0.f, 0.f, 0.f}; } };
template <class Epi, class Sched, class Init = ZeroInit>
__device__ __forceinline__ void gemm_phase(LAS unsigned char* lds, const Gemm g, const Sched& S, const Epi& E, const int tid, const Init& I = Init()) {
    const int wid = __builtin_amdgcn_readfirstlane(tid >> 6), lane = tid & 63, wr = wid >> 2, wc = wid & 3, fr = lane & 15, fq = lane >> 4;
    const int K = g.K;
    unsigned voffA[2], voffB[2];
#pragma unroll
    for (int i = 0; i < 2; ++i) { int R, C; stage_rc(tid * 16 + i * 8192, R, C); const int Rb = (R & ~31) + perm32(R & 31);
        voffA[i] = (unsigned)(R * K + C) * 2u; voffB[i] = (unsigned)(Rb * K + C) * 2u; }
    const size_t kstep = (size_t)(BK * 2);
    const size_t hstep = (size_t)HALF * K * 2;
    const size_t tstep = 2 * hstep;
    const unsigned ldsw = (unsigned)wid * 1024u;
    const int aoff = lds_byte(wr * 64 + fr, fq * 8), boff = lds_byte(wc * 32 + fr, fq * 8);
#define PG8_SA(b, h) (((b) * 2 + (h)) * HTB)
#define PG8_SB(b, h) ((4 + (b) * 2 + (h)) * HTB)
#define PG8_STAGE(bufoff, gbase, voff) do { _Pragma("unroll") for (int _i = 0; _i < 2; ++_i) \
        __builtin_amdgcn_global_load_lds((const unsigned*)((const char*)(gbase) + (voff)[_i]), (LAS unsigned*)(lds + (bufoff) + ldsw + _i * 8192), 16, 0, 0); } while (0)
#define PG8_LDA(dst, b, h) do { _Pragma("unroll") for (int m = 0; m < 4; ++m) _Pragma("unroll") for (int k = 0; k < 2; ++k) dst[m][k] = *(const LAS bf16x8*)(lds + PG8_SA(b, h) + aoff + m * 2048 + k * 1024); } while (0)
#define PG8_LDB(dst, b, h) do { _Pragma("unroll") for (int n = 0; n < 2; ++n) _Pragma("unroll") for (int k = 0; k < 2; ++k) dst[n][k] = *(const LAS bf16x8*)(lds + PG8_SB(b, h) + boff + n * 2048 + k * 1024); } while (0)
#define PG8_MMA(ai, bj, At, Bt) do { __builtin_amdgcn_s_setprio(1); _Pragma("unroll") for (int m = 0; m < 4; ++m) _Pragma("unroll") for (int n = 0; n < 2; ++n) _Pragma("unroll") for (int k = 0; k < 2; ++k) \
        acc[ai][bj][m][n] = __builtin_amdgcn_mfma_f32_16x16x32_bf16(Bt[n][k], At[m][k], acc[ai][bj][m][n], 0, 0, 0); __builtin_amdgcn_s_setprio(0); } while (0)
#define PG8_WAIT_V(n) asm volatile("s_waitcnt vmcnt(" #n ")" ::: "memory")
#define PG8_WAIT_L(n) asm volatile("s_waitcnt lgkmcnt(" #n ")" ::: "memory")
#define PG8_BAR __builtin_amdgcn_s_barrier()
#define PG8_SCHED __builtin_amdgcn_sched_barrier(0)
    Unit cur, nxt; int ui = 0;
    if (!S.next(0, cur)) return;
    f32x4 acc[2][2][4][2];
    I(acc, cur, wr, wc, fr, fq);
    bf16x8 At[4][2], B0[2][2], B1[2][2];
    const char* cA = (const char*)g.A + (size_t)cur.pm * tstep + cur.kb; const char* cB = (const char*)g.Bt + (size_t)cur.pn * tstep + cur.kb;
    PG8_STAGE(PG8_SB(0, 0), cB, voffB); PG8_STAGE(PG8_SA(0, 0), cA, voffA); PG8_STAGE(PG8_SB(0, 1), cB + hstep, voffB); PG8_STAGE(PG8_SA(0, 1), cA + hstep, voffA);
    if (wr == 1) PG8_BAR;
    PG8_WAIT_V(4); PG8_BAR;
    PG8_STAGE(PG8_SB(1, 0), cB + kstep, voffB); PG8_STAGE(PG8_SA(1, 0), cA + kstep, voffA); PG8_STAGE(PG8_SB(1, 1), cB + hstep + kstep, voffB);
    PG8_WAIT_V(6); PG8_BAR;
    for (;;) {
        const bool has_next = S.next(ui + 1, nxt);
        const char* nA = has_next ? (const char*)g.A + (size_t)nxt.pm * tstep + nxt.kb : cA; const char* nB = has_next ? (const char*)g.Bt + (size_t)nxt.pn * tstep + nxt.kb : cB;
        const int nt = cur.nt;
        for (int t = 0; t < nt; t += 2) {
            const bool last = (t == nt - 2);
            const char* a1 = cA + (size_t)(t + 1) * kstep;
            const char* a2 = last ? nA : cA + (size_t)(t + 2) * kstep; const char* b2 = last ? nB : cB + (size_t)(t + 2) * kstep;
            const char* a3 = a2 + kstep; const char* b3 = b2 + kstep;
            PG8_LDB(B0, 0, 0); PG8_SCHED; PG8_LDA(At, 0, 0); PG8_STAGE(PG8_SA(1, 1), a1 + hstep, voffA);
            PG8_WAIT_L(8); PG8_BAR; PG8_WAIT_L(0); PG8_MMA(0, 0, At, B0); PG8_BAR; PG8_SCHED;
            PG8_LDB(B1, 0, 1); PG8_STAGE(PG8_SB(0, 0), b2, voffB);
            PG8_BAR; PG8_WAIT_L(0); PG8_MMA(0, 1, At, B1); PG8_BAR;
            PG8_LDA(At, 0, 1); PG8_STAGE(PG8_SA(0, 0), a2, voffA);
            PG8_BAR; PG8_WAIT_L(0); PG8_MMA(1, 0, At, B0); PG8_BAR; PG8_SCHED;
            PG8_STAGE(PG8_SB(0, 1), b2 + hstep, voffB);
            PG8_WAIT_V(6); PG8_BAR; PG8_MMA(1, 1, At, B1); PG8_BAR;
            PG8_LDB(B0, 1, 0); PG8_SCHED; PG8_LDA(At, 1, 0); PG8_STAGE(PG8_SA(0, 1), a2 + hstep, voffA);
            PG8_WAIT_L(8); PG8_BAR; PG8_WAIT_L(0); PG8_MMA(0, 0, At, B0); PG8_BAR; PG8_SCHED;
            PG8_LDB(B1, 1, 1); PG8_STAGE(PG8_SB(1, 0), b3, voffB);
            PG8_BAR; PG8_WAIT_L(0); PG8_MMA(0, 1, At, B1); PG8_BAR;
            PG8_LDA(At, 1, 1); PG8_STAGE(PG8_SA(1, 0), a3, voffA);
            PG8_BAR; PG8_WAIT_L(0); PG8_MMA(1, 0, At, B0); PG8_BAR; PG8_SCHED;
            PG8_STAGE(PG8_SB(1, 1), b3 + hstep, voffB);
            PG8_WAIT_V(6); PG8_BAR; PG8_MMA(1, 1, At, B1); PG8_BAR;
        }
        E(acc, cur, wr, wc, fr, fq);
        if (!has_next) break;
        if (!cur.keep) I(acc, nxt, wr, wc, fr, fq);
        cur = nxt; cA = nA; cB = nB; ++ui;
    }
    PG8_WAIT_V(0);
    if (wr == 0) PG8_BAR;
    PG8_BAR;
#undef PG8_SA
#undef PG8_SB
#undef PG8_STAGE
#undef PG8_LDA
#undef PG8_LDB
#undef PG8_MMA
#undef PG8_WAIT_V
#undef PG8_WAIT_L
#undef PG8_BAR
#undef PG8_SCHED
}

__device__ __forceinline__ u32x4 pack8(f32x4 v0, f32x4 v1) { u32x4 w; w.x = cvt_pk_bf16(v0[0], v0[1]); w.y = cvt_pk_bf16(v0[2], v0[3]); w.z = cvt_pk_bf16(v1[0], v1[1]); w.w = cvt_pk_bf16(v1[2], v1[3]); return w; }

__device__ __forceinline__ u32x2 pack4(f32x4 v) { u32x2 w; w.x = cvt_pk_bf16(v[0], v[1]); w.y = cvt_pk_bf16(v[2], v[3]); return w; }
__device__ __forceinline__ float sumsq8(f32x4 a, f32x4 b) { return (a[0] * a[0] + a[1] * a[1]) + (a[2] * a[2] + a[3] * a[3]) + (b[0] * b[0] + b[1] * b[1]) + (b[2] * b[2] + b[3] * b[3]); }
template <bool GELU = false>
__device__ __forceinline__ void head_ss_exchange(const f32x4 (&acc)[2][2][4][2], LAS float* xch, int wr, int wc, int fr, int fq, float (&tot)[2][4][2]) {
#pragma unroll
    for (int ai = 0; ai < 2; ++ai)
#pragma unroll
        for (int m = 0; m < 4; ++m)
#pragma unroll
            for (int bj = 0; bj < 2; ++bj) { f32x4 a0 = acc[ai][bj][m][0], a1 = acc[ai][bj][m][1];
                if (GELU) {
#pragma unroll
                    for (int j = 0; j < 4; ++j) { a0[j] = gelu_tanh(a0[j]); a1[j] = gelu_tanh(a1[j]); } }
                float ss = sumsq8(a0, a1); ss += __shfl_xor(ss, 16); ss += __shfl_xor(ss, 32);
                if (fq == 0) xch[((wr * 128 + (ai * 4 + m) * 16 + fr) * 2 + bj) * 4 + wc] = ss; }
    asm volatile("s_waitcnt lgkmcnt(0)" ::: "memory"); __builtin_amdgcn_s_barrier(); asm volatile("" ::: "memory");
#pragma unroll
    for (int ai = 0; ai < 2; ++ai)
#pragma unroll
        for (int m = 0; m < 4; ++m)
#pragma unroll
            for (int bj = 0; bj < 2; ++bj) { const f32x4 p = *(const LAS f32x4*)(xch + ((wr * 128 + (ai * 4 + m) * 16 + fr) * 2 + bj) * 4); tot[ai][m][bj] = (p[0] + p[1]) + (p[2] + p[3]); }
}
struct EpiInProj {
    LAS float* xch;
    __device__ __forceinline__ void operator()(const f32x4 (&acc)[2][2][4][2], const Unit& u, int wr, int wc, int fr, int fq) const {
        CArgs* ap = ARGP(); unsigned char* ws = ap->ws; unsigned char* ob = (unsigned char*)ap->out;
        bf16_t* QALL = (bf16_t*)(ob + R0_QB); bf16_t* Kb = (bf16_t*)(ob + R0_KB); bf16_t* GVb = (bf16_t*)(ob + R0_VN);
        bf16_t* Vb = (bf16_t*)(ws + WS_VB); bf16_t* Ub = (bf16_t*)(ws + WS_UB); bf16_t* GATES = (bf16_t*)(ws + WS_GATES);
        float* SSVP = (float*)(ws + WS_SMALL + SM_SSVP); const float* CS = (const float*)(ws + WS_SMALL + SM_CS);
        const float* q_norm = ap->q_norm; const float* k_norm = ap->k_norm; const float* mq_norm = ap->mq_norm;
        const int pn = u.pn; const int row0 = u.pm * BM + wr * 64 + fr, cl = wc * 32 + 8 * fq;
        if (pn < 5) {
            const bool isk = (pn == 4);
            float tot[2][4][2];
            head_ss_exchange(acc, xch, wr, wc, fr, fq, tot);
            const int hf = wc >> 1, f0 = 16 * (wc & 1) + 4 * fq, dh = 64 * hf + f0;
            const float* gn = isk ? k_norm : q_norm;
            const f32x4 g0 = *(const f32x4*)(gn + dh), g1 = *(const f32x4*)(gn + dh + 32);
#pragma unroll
            for (int ai = 0; ai < 2; ++ai) {
                f32x4 csv[4][2];
#pragma unroll
                for (int m = 0; m < 4; ++m) { const int t = row0 + ai * HALF + m * 16; const int pos = hf ? (t & 63) : (t >> 6);
                    const float* csp = CS + (size_t)(pos * 32 + f0) * 2; csv[m][0] = *(const f32x4*)csp; csv[m][1] = *(const f32x4*)(csp + 4); }
#pragma unroll
                for (int m = 0; m < 4; ++m) { const int t = row0 + ai * HALF + m * 16;
                    const f32x4 cs0 = csv[m][0], cs1 = csv[m][1];
                    const f32x4 cc = {cs0[0], cs0[2], cs1[0], cs1[2]}, sn = {cs0[1], cs0[3], cs1[1], cs1[3]};
#pragma unroll
                    for (int bj = 0; bj < 2; ++bj) { f32x4 v0 = acc[ai][bj][m][0], v1 = acc[ai][bj][m][1];
                        { const float r = __builtin_amdgcn_rsqf(tot[ai][m][bj] * (1.f / 128.f) + EPS); v0 *= r; v1 *= r; }
                        const f32x4 y0 = v0 * g0, y1 = v1 * g1;
                        const f32x4 o0 = y0 * cc - y1 * sn, o1 = y1 * cc + y0 * sn;
                        bf16_t* dst = isk ? Kb + (size_t)t * 256 + bj * 128 + dh : QALL + (size_t)t * 1536 + (pn * 2 + bj) * 128 + dh;
                        *(u32x2*)dst = pack4(o0); *(u32x2*)(dst + 32) = pack4(o1); } }
            }
            return;
        }
        if (pn >= 8 && pn < 12) {
            const bool isqm = pn >= 10;
            f32x4 g0 = {1.f, 1.f, 1.f, 1.f}, g1 = g0;
            if (isqm) { g0 = *(const f32x4*)(mq_norm + cl); g1 = *(const f32x4*)(mq_norm + cl + 4); }
            float tot[2][4][2];
            if (isqm) head_ss_exchange<false>(acc, xch, wr, wc, fr, fq, tot); else head_ss_exchange<true>(acc, xch, wr, wc, fr, fq, tot);
#pragma unroll
            for (int ai = 0; ai < 2; ++ai)
#pragma unroll
                for (int m = 0; m < 4; ++m) { const int t = row0 + ai * HALF + m * 16;
#pragma unroll
                    for (int bj = 0; bj < 2; ++bj) { f32x4 v0 = acc[ai][bj][m][0], v1 = acc[ai][bj][m][1];
                        if (isqm) { const float r = __builtin_amdgcn_rsqf(tot[ai][m][bj] * (1.f / 128.f) + EPS);
                            *(u32x4*)(QALL + (size_t)t * 1536 + 1024 + (pn - 10) * 256 + bj * HALF + cl) = pack8(v0 * r * g0, v1 * r * g1); }
                        else {
#pragma unroll
                            for (int j = 0; j < 4; ++j) { v0[j] = gelu_tanh(v0[j]); v1[j] = gelu_tanh(v1[j]); }
                            *(u32x4*)(GVb + (size_t)t * 512 + (pn - 8) * 256 + bj * HALF + cl) = pack8(v0, v1); } }
                    if (!isqm && wc == 0 && fq == 0) SSVP[(size_t)t * 2 + (pn - 8)] = tot[ai][m][0] + tot[ai][m][1]; }
            return;
        }
        int mode, ld, c0; bf16_t* base;
        if (pn == 5)      { base = Vb;    ld = 256;  c0 = 0; mode = 0; }
        else if (pn < 8)  { base = Ub;    ld = 512;  c0 = (pn - 6) * 256; mode = 1; }
        else              { base = GATES; ld = 6144; c0 = (pn - 12) * 256; mode = 2; }
#pragma unroll
        for (int ai = 0; ai < 2; ++ai)
#pragma unroll
            for (int m = 0; m < 4; ++m) { const size_t roff = (size_t)(row0 + ai * HALF + m * 16) * ld + c0 + cl;
#pragma unroll
                for (int bj = 0; bj < 2; ++bj) { f32x4 v0 = acc[ai][bj][m][0], v1 = acc[ai][bj][m][1];
                    if (mode == 1) {
#pragma unroll
                        for (int j = 0; j < 4; ++j) { v0[j] = gelu_tanh(v0[j]); v1[j] = gelu_tanh(v1[j]); } }
                    else if (mode == 2) {
#pragma unroll
                        for (int j = 0; j < 4; ++j) { v0[j] = sigmoidf_(v0[j]); v1[j] = sigmoidf_(v1[j]); } }
                    *(u32x4*)(base + roff + bj * HALF) = pack8(v0, v1); } }
    }
};
struct EpiMemKV {
    LAS float* xch;
    __device__ __forceinline__ void operator()(const f32x4 (&acc)[2][2][4][2], const Unit& u, int wr, int wc, int fr, int fq) const {
        CArgs* ap = ARGP(); unsigned char* ws = ap->ws; bf16_t* KMb = (bf16_t*)(ws + WS_SMALL + SM_KMB); bf16_t* VMb = (bf16_t*)(ws + WS_SMALL + SM_VMB); const float* mk_norm = ap->mk_norm;
        const int pn = u.pn; const int row0 = u.pm * BM + wr * 64 + fr, cl = wc * 32 + 8 * fq;
        float tot[2][4][2];
        if (pn < 2) head_ss_exchange(acc, xch, wr, wc, fr, fq, tot);
        const f32x4 g0 = *(const f32x4*)(mk_norm + cl), g1 = *(const f32x4*)(mk_norm + cl + 4);
#pragma unroll
        for (int ai = 0; ai < 2; ++ai)
#pragma unroll
            for (int m = 0; m < 4; ++m) { const size_t roff = (size_t)(pn & 1) * 65536 + (size_t)(row0 + ai * HALF + m * 16) * 256 + cl;
#pragma unroll
                for (int bj = 0; bj < 2; ++bj) { f32x4 v0 = acc[ai][bj][m][0], v1 = acc[ai][bj][m][1];
                    if (pn < 2) { const float r = __builtin_amdgcn_rsqf(tot[ai][m][bj] * (1.f / 128.f) + EPS); v0 = v0 * r * g0; v1 = v1 * r * g1; *(u32x4*)(KMb + roff + bj * HALF) = pack8(v0, v1); }
                    else { *(u32x4*)(VMb + roff + bj * HALF) = pack8(v0, v1); } } }
    }
};
__device__ __forceinline__ void unpack8(const u32x4 w, f32x4& lo, f32x4& hi) {
    lo[0] = __uint_as_float(w.x << 16); lo[1] = __uint_as_float(w.x & 0xffff0000u); lo[2] = __uint_as_float(w.y << 16); lo[3] = __uint_as_float(w.y & 0xffff0000u);
    hi[0] = __uint_as_float(w.z << 16); hi[1] = __uint_as_float(w.z & 0xffff0000u); hi[2] = __uint_as_float(w.w << 16); hi[3] = __uint_as_float(w.w & 0xffff0000u);
}
struct EpiBranch {
    __device__ __forceinline__ void operator()(f32x4 (&acc)[2][2][4][2], const Unit& u, int wr, int wc, int fr, int fq) const {
        unsigned char* ws = ARGP()->ws; const bf16_t* GATES = (const bf16_t*)(ws + WS_GATES); bf16_t* MERGED = (bf16_t*)(ws + WS_R0);
        const int br = u.tag; const int row0 = u.pm * BM + wr * 64 + fr, col0 = u.pn * BM + wc * 32 + 8 * fq;
        const bf16_t* gp = GATES + (size_t)row0 * 6144 + br * 2048 + col0;
#pragma unroll
        for (int ai = 0; ai < 2; ++ai) {
            u32x4 ga[4][2], gb[4][2];
#pragma unroll
            for (int m = 0; m < 4; ++m)
#pragma unroll
                for (int bj = 0; bj < 2; ++bj) { const bf16_t* p = gp + (size_t)(ai * HALF + m * 16) * 6144 + bj * HALF;
                    ga[m][bj] = *(const u32x4*)p; if (br < 2) gb[m][bj] = *(const u32x4*)(p + 2048); }
#pragma unroll
            for (int m = 0; m < 4; ++m)
#pragma unroll
                for (int bj = 0; bj < 2; ++bj) { f32x4 g0, g1; unpack8(ga[m][bj], g0, g1);
                    if (br < 2) { f32x4 h0, h1; unpack8(gb[m][bj], h0, h1);
#pragma unroll
                        for (int j = 0; j < 4; ++j) { g0[j] *= __builtin_amdgcn_rcpf(h0[j]); g1[j] *= __builtin_amdgcn_rcpf(h1[j]); }
                        acc[ai][bj][m][0] *= g0; acc[ai][bj][m][1] *= g1; }
                    else { *(u32x4*)(MERGED + (size_t)(row0 + ai * HALF + m * 16) * DM + col0 + bj * HALF) = pack8(acc[ai][bj][m][0] * g0, acc[ai][bj][m][1] * g1); } }
        }
    }
};
struct ResidInit {
    int which;
    __device__ __forceinline__ void operator()(f32x4 (&acc)[2][2][4][2], const Unit& u, int wr, int wc, int fr, int fq) const {
        CArgs* ap = ARGP(); const float* R = which ? (const float*)ap->out : ap->x;
        const int row0 = u.pm * BM + wr * 64 + fr, col0 = u.pn * BM + wc * 32 + 8 * fq;
#pragma unroll
        for (int ai = 0; ai < 2; ++ai)
#pragma unroll
            for (int m = 0; m < 4; ++m)
#pragma unroll
                for (int bj = 0; bj < 2; ++bj) { const float* p = R + (size_t)(row0 + ai * HALF + m * 16) * DM + col0 + bj * HALF; acc[ai][bj][m][0] = *(const f32x4*)p; acc[ai][bj][m][1] = *(const f32x4*)(p + 4); }
    }
};
struct EpiOut {
    LAS float* xch; f32x4 g[2][2];
    int gpn;
    __device__ __forceinline__ void operator()(const f32x4 (&acc)[2][2][4][2], const Unit& u, int wr, int wc, int fr, int fq) const {
        CArgs* ap = ARGP(); unsigned char* ws = ap->ws; const float* G = ap->norm_ffn; float* X1 = ap->out; bf16_t* A2 = (bf16_t*)(ws + WS_H); float* ROWSSP = (float*)(ws + WS_SMALL + SM_ROWSSP);
        float tot[2][4][2];
        head_ss_exchange(acc, xch, wr, wc, fr, fq, tot);
        const int row0 = u.pm * BM + wr * 64 + fr, col0 = u.pn * BM + wc * 32 + 8 * fq;
        f32x4 gl[2][2];
        if (u.pn == gpn) {
#pragma unroll
            for (int bj = 0; bj < 2; ++bj) { gl[bj][0] = g[bj][0]; gl[bj][1] = g[bj][1]; }
        } else {
#pragma unroll
            for (int bj = 0; bj < 2; ++bj) { gl[bj][0] = *(const f32x4*)(G + col0 + bj * HALF); gl[bj][1] = *(const f32x4*)(G + col0 + bj * HALF + 4); }
        }
#pragma unroll
        for (int ai = 0; ai < 2; ++ai)
#pragma unroll
            for (int m = 0; m < 4; ++m) { const int row = row0 + ai * HALF + m * 16;
#pragma unroll
                for (int bj = 0; bj < 2; ++bj) { const size_t off = (size_t)row * DM + col0 + bj * HALF;
                    const f32x4 v0 = acc[ai][bj][m][0], v1 = acc[ai][bj][m][1];
                    *(f32x4*)(X1 + off) = v0; *(f32x4*)(X1 + off + 4) = v1;
                    *(u32x4*)(A2 + off) = pack8(v0 * gl[bj][0], v1 * gl[bj][1]); }
                if (wc == 0 && fq == 0) ROWSSP[(size_t)row * 8 + u.pn] = tot[ai][m][0] + tot[ai][m][1]; }
    }
};
struct EpiUp {
    int pm0; float rs0[2][4];
    __device__ static __forceinline__ void load_rs(const float* ROWSSP, int row0, float (&rs)[2][4]) {
        float rsv[2][4];
#pragma unroll
        for (int ai = 0; ai < 2; ++ai)
#pragma unroll
            for (int m = 0; m < 4; ++m) { const float* pp = ROWSSP + (size_t)(row0 + ai * HALF + m * 16) * 8; const f32x4 pa = *(const f32x4*)pp, pb = *(const f32x4*)(pp + 4);
                rsv[ai][m] = ((pa[0] + pa[1]) + (pa[2] + pa[3])) + ((pb[0] + pb[1]) + (pb[2] + pb[3])); }
#pragma unroll
        for (int ai = 0; ai < 2; ++ai)
#pragma unroll
            for (int m = 0; m < 4; ++m) rs[ai][m] = __builtin_amdgcn_rsqf(rsv[ai][m] * (1.0f / DM) + EPS);
    }
    __device__ __forceinline__ void operator()(const f32x4 (&acc)[2][2][4][2], const Unit& u, int wr, int wc, int fr, int fq) const {
        unsigned char* ws = ARGP()->ws; const float* ROWSSP = (const float*)(ws + WS_SMALL + SM_ROWSSP); bf16_t* U2 = (bf16_t*)(ws + WS_R0);
        const int row0 = u.pm * BM + wr * 64 + fr, col0 = u.pn * BM + wc * 32 + 8 * fq;
        float rs[2][4];
        if (u.pm == pm0) {
#pragma unroll
            for (int ai = 0; ai < 2; ++ai)
#pragma unroll
                for (int m = 0; m < 4; ++m) rs[ai][m] = rs0[ai][m];
        } else load_rs(ROWSSP, row0, rs);
#pragma unroll
        for (int ai = 0; ai < 2; ++ai)
#pragma unroll
            for (int m = 0; m < 4; ++m) { const int row = row0 + ai * HALF + m * 16;
#pragma unroll
                for (int bj = 0; bj < 2; ++bj) { f32x4 v0 = acc[ai][bj][m][0] * rs[ai][m], v1 = acc[ai][bj][m][1] * rs[ai][m];
#pragma unroll
                    for (int j = 0; j < 4; ++j) { const float a = fmaxf(v0[j], 0.f), b = fmaxf(v1[j], 0.f); v0[j] = a * a; v1[j] = b * b; }
                    *(u32x4*)(U2 + (size_t)row * DFF + col0 + bj * HALF) = pack8(v0, v1); } }
    }
};
struct EpiDown {
    __device__ __forceinline__ void operator()(const f32x4 (&acc)[2][2][4][2], const Unit& u, int wr, int wc, int fr, int fq) const {
        float* OUT = ARGP()->out;
        const int row0 = u.pm * BM + wr * 64 + fr, col0 = u.pn * BM + wc * 32 + 8 * fq;
#pragma unroll
        for (int ai = 0; ai < 2; ++ai)
#pragma unroll
            for (int m = 0; m < 4; ++m)
#pragma unroll
                for (int bj = 0; bj < 2; ++bj) { float* p = OUT + (size_t)(row0 + ai * HALF + m * 16) * DM + col0 + bj * HALF; *(f32x4*)p = acc[ai][bj][m][0]; *(f32x4*)(p + 4) = acc[ai][bj][m][1]; }
    }
};
}

namespace att {
constexpr int D = 128, NW = 8, QBLK = 32, KVBLK = 64;
constexpr float SCALE = 0.088388347648318440f;
constexpr float THR = 8.f;
constexpr size_t SHM_V = KVBLK * D * 2, SHM_K = KVBLK * D * 2, SHM_ATTN = 2 * SHM_V + 2 * SHM_K + NW * 64 * 4;
#define KSWZ(row, colB) ((row) * 256 + ((colB) ^ (((row) & 7) << 4)))
#define SBAR() __builtin_amdgcn_sched_barrier(0)
__device__ __forceinline__ int crow(int r, int hi) { return (r & 3) + 8 * (r >> 2) + 4 * hi; }
__device__ __forceinline__ void partialSM(f32x16& p0, f32x16& p1, float& m_reg, float& mn, float& alpha) {
  constexpr float C = SCALE * 1.4426950408889634f;
  float pmax = p0[0];
#pragma unroll
  for (int r = 1; r < 16; ++r) pmax = fmaxf(pmax, p0[r]);
#pragma unroll
  for (int r = 0; r < 16; ++r) pmax = fmaxf(pmax, p1[r]);
  { auto rr = __builtin_amdgcn_permlane32_swap(__float_as_uint(pmax), __float_as_uint(pmax), false, false);
    pmax = fmaxf(__uint_as_float(rr[0]), __uint_as_float(rr[1])); }
  if (__builtin_expect(__all(pmax - m_reg <= THR / SCALE), 1)) { mn = m_reg; alpha = 1.f; }
  else { mn = fmaxf(m_reg, pmax); alpha = __builtin_amdgcn_exp2f((m_reg - mn) * C); m_reg = mn; }
  float mnC = -mn * C;
#pragma unroll
  for (int r = 0; r < 16; ++r) p0[r] = fmaf(p0[r], C, mnC);
#pragma unroll
  for (int r = 0; r < 16; ++r) p1[r] = fmaf(p1[r], C, mnC);
#pragma unroll
  for (int r = 0; r < 16; ++r) p0[r] = __builtin_amdgcn_exp2f(p0[r]);
}
__device__ __forceinline__ void finishSM(f32x16& p0, f32x16& p1, float alpha, float& l_reg, bf16x8& pa0, bf16x8& pa1, bf16x8& pa2, bf16x8& pa3) {
#pragma unroll
  for (int r = 0; r < 16; ++r) p1[r] = __builtin_amdgcn_exp2f(p1[r]);
  float ps = 0;
#pragma unroll
  for (int r = 0; r < 16; ++r) ps += p0[r];
#pragma unroll
  for (int r = 0; r < 16; ++r) ps += p1[r];
  { auto rr = __builtin_amdgcn_permlane32_swap(__float_as_uint(ps), __float_as_uint(ps), false, false);
    ps = __uint_as_float(rr[0]) + __uint_as_float(rr[1]); }
  l_reg = l_reg * alpha + ps;
#define PK4(P, BASE, OUT) do { unsigned a0 = cvt_pk_bf16(P[BASE + 0], P[BASE + 1]), a1 = cvt_pk_bf16(P[BASE + 2], P[BASE + 3]);   \
    unsigned b0 = cvt_pk_bf16(P[BASE + 4], P[BASE + 5]), b1 = cvt_pk_bf16(P[BASE + 6], P[BASE + 7]);                              \
    auto r0 = __builtin_amdgcn_permlane32_swap(a0, b0, false, false); auto r1 = __builtin_amdgcn_permlane32_swap(a1, b1, false, false); \
    u32x4 w = {r0[0], r1[0], r0[1], r1[1]}; OUT = *reinterpret_cast<bf16x8*>(&w); } while (0)
  PK4(p0, 0, pa0); PK4(p0, 8, pa1); PK4(p1, 0, pa2); PK4(p1, 8, pa3);
#undef PK4
}
__device__ __forceinline__ void qkt(f32x16& p0, f32x16& p1, const bf16_t* Ks, const bf16x8* qr, int r32, int hi) {
  p0 = f32x16{}; p1 = f32x16{};
#pragma unroll
  for (int d0 = 0; d0 < 8; ++d0) { int cb = (d0 * 16 + hi * 8) * 2;
    bf16x8 b0 = *reinterpret_cast<const bf16x8*>((const char*)Ks + KSWZ(r32, cb));
    bf16x8 b1 = *reinterpret_cast<const bf16x8*>((const char*)Ks + KSWZ(32 + r32, cb));
    p0 = __builtin_amdgcn_mfma_f32_32x32x16_bf16(b0, qr[d0], p0, 0, 0, 0);
    p1 = __builtin_amdgcn_mfma_f32_32x32x16_bf16(b1, qr[d0], p1, 0, 0, 0); }
}
__device__ __forceinline__ int v_st(int k, int c) { const int kk = (k & ~0xC) | ((k & 4) << 1) | ((k & 8) >> 1); return ((kk >> 3) * 4 + (c >> 5)) * 512 + ((kk & 7) * 32 + (c & 31)) * 2; }
__device__ __forceinline__ int v_rd_base(int lane) { return ((lane & 3) << 3) | (((lane >> 2) & 3) << 6) | (((lane >> 4) & 1) << 5) | (((lane >> 5) & 1) << 8); }
constexpr int v_rd_off(int d0, int ks, int half) { return d0 * 512 + ks * 4096 + half * 2048; }
template <int OFF> __device__ __forceinline__ s16x4 tr_read(int vb) {
  s16x4 r; asm volatile("ds_read_b64_tr_b16 %0, %1 offset:%2" : "=&v"(r) : "v"(vb), "i"(OFF) : "memory"); return r;
}
template <int D0> __device__ __forceinline__ void pv_one(f32x16& od, int vb, bf16x8 pa0, bf16x8 pa1, bf16x8 pa2, bf16x8 pa3) {
  const s16x4 l0 = tr_read<v_rd_off(D0, 0, 0)>(vb), h0 = tr_read<v_rd_off(D0, 0, 1)>(vb), l1 = tr_read<v_rd_off(D0, 1, 0)>(vb), h1 = tr_read<v_rd_off(D0, 1, 1)>(vb);
  const s16x4 l2 = tr_read<v_rd_off(D0, 2, 0)>(vb), h2 = tr_read<v_rd_off(D0, 2, 1)>(vb), l3 = tr_read<v_rd_off(D0, 3, 0)>(vb), h3 = tr_read<v_rd_off(D0, 3, 1)>(vb);
  asm volatile("s_waitcnt lgkmcnt(0)" ::: "memory"); SBAR();
#define PK(L, H) (bf16x8){L[0], L[1], L[2], L[3], H[0], H[1], H[2], H[3]}
  od = __builtin_amdgcn_mfma_f32_32x32x16_bf16(pa0, PK(l0, h0), od, 0, 0, 0);
  od = __builtin_amdgcn_mfma_f32_32x32x16_bf16(pa1, PK(l1, h1), od, 0, 0, 0);
  od = __builtin_amdgcn_mfma_f32_32x32x16_bf16(pa2, PK(l2, h2), od, 0, 0, 0);
  od = __builtin_amdgcn_mfma_f32_32x32x16_bf16(pa3, PK(l3, h3), od, 0, 0, 0);
#undef PK
}
__device__ __forceinline__ void pv_d0(f32x16* o, int vb, bf16x8 pa0, bf16x8 pa1, bf16x8 pa2, bf16x8 pa3) {
  pv_one<0>(o[0], vb, pa0, pa1, pa2, pa3); pv_one<1>(o[1], vb, pa0, pa1, pa2, pa3); pv_one<2>(o[2], vb, pa0, pa1, pa2, pa3); pv_one<3>(o[3], vb, pa0, pa1, pa2, pa3);
}
template <int LDQ, int LDK, int LDO>
__device__ __forceinline__ void attn_dense_body(const bf16_t* __restrict__ Qb, const bf16_t* __restrict__ Kh, const bf16_t* __restrict__ Vh,
                                                bf16_t* __restrict__ Ob, int seq, char* lds, const float* __restrict__ ssq, const int tid) {
  const int wid = tid >> 6, lane = tid & 63, r32 = lane & 31, hi = lane >> 5;
  bf16_t* V_lds = (bf16_t*)lds; bf16_t* K_lds = (bf16_t*)(lds + 2 * SHM_V);
  float* ws = (float*)(lds + 2 * SHM_V + 2 * SHM_K) + wid * 64; float* li_l = ws; float* al_l = ws + 32;
  float m_reg = -1e30f, l_reg = 0; f32x16 o[4] = {}; bf16x8 qr[8];
  const bf16_t* Qw = Qb + (long)(wid * QBLK + r32) * LDQ + hi * 8;
  const float rq = __builtin_amdgcn_rsqf(ssq[(wid * QBLK + r32) * 16] * (1.f / 128.f) + EPS);
#pragma unroll
  for (int d0 = 0; d0 < 8; ++d0) { const u32x4 w = *reinterpret_cast<const u32x4*>(Qw + d0 * 16); f32x4 lo, hi2; pg8::unpack8(w, lo, hi2);
    const u32x4 o = pg8::pack8(lo * rq, hi2 * rq); qr[d0] = *reinterpret_cast<const bf16x8*>(&o); }
  const int sr = tid >> 4, sc = (tid & 15) * 8, vst0 = v_st(sr, sc), vst1 = v_st(32 + sr, sc);
  const int vb0 = (int)(uintptr_t)V_lds + v_rd_base(lane);
  struct { bf16x8 vs0, vs1, ks0, ks1; } sr_[2];
#define SLOAD(i, k0) do { sr_[i].vs0 = *reinterpret_cast<const bf16x8*>(&Vh[(long)((k0) + sr) * LDK + sc]); sr_[i].vs1 = *reinterpret_cast<const bf16x8*>(&Vh[(long)((k0) + 32 + sr) * LDK + sc]); \
    sr_[i].ks0 = *reinterpret_cast<const bf16x8*>(&Kh[(long)((k0) + sr) * LDK + sc]); sr_[i].ks1 = *reinterpret_cast<const bf16x8*>(&Kh[(long)((k0) + 32 + sr) * LDK + sc]); } while (0)
#define SWRITE(b, i) do { *(bf16x8*)((char*)V_lds + (b) * SHM_V + vst0) = sr_[i].vs0;          \
    *(bf16x8*)((char*)V_lds + (b) * SHM_V + vst1) = sr_[i].vs1; int kc = sc * 2;               \
    *(bf16x8*)((char*)K_lds + (b) * SHM_K + KSWZ(sr, kc)) = sr_[i].ks0;                       \
    *(bf16x8*)((char*)K_lds + (b) * SHM_K + KSWZ(32 + sr, kc)) = sr_[i].ks1; } while (0)
#define SWAIT() asm volatile("s_waitcnt vmcnt(4)" ::: "memory")
#define RESC(a) do { if (__any((a) < 1.f)) { if (hi == 0) al_l[r32] = (a); asm volatile("s_waitcnt lgkmcnt(0)" ::: "memory"); \
    _Pragma("unroll") for (int d = 0; d < 4; ++d) _Pragma("unroll") for (int r = 0; r < 16; ++r) o[d][r] *= al_l[crow(r, hi)]; } } while (0)
  f32x16 pA0, pA1, pB0, pB1; float mnA, mnB, alA, alB; bf16x8 pa0, pa1, pa2, pa3; const int NT = seq / KVBLK;
  constexpr int SE = 0, SO = 1;
  SLOAD(SE, 0); asm volatile("s_waitcnt vmcnt(0)" ::: "memory"); SWRITE(0, SE); __syncthreads();
  qkt(pA0, pA1, K_lds, qr, r32, hi); partialSM(pA0, pA1, m_reg, mnA, alA);
  SLOAD(SO, KVBLK); if (2 < NT) SLOAD(SE, 2 * KVBLK);
  SWAIT(); SWRITE(1, SO); __syncthreads();
  for (int j = 1; j + 1 < NT; j += 2) {
    SBAR(); qkt(pB0, pB1, (bf16_t*)((char*)K_lds + SHM_K), qr, r32, hi);
    finishSM(pA0, pA1, alA, l_reg, pa0, pa1, pa2, pa3); SBAR();
    SLOAD(SO, (j + 2) * KVBLK); SBAR();
    pv_d0(o, vb0, pa0, pa1, pa2, pa3); partialSM(pB0, pB1, m_reg, mnB, alB);
    __syncthreads(); SWAIT(); SWRITE(0, SE);
    RESC(alB); __syncthreads();
    SBAR(); qkt(pA0, pA1, K_lds, qr, r32, hi);
    finishSM(pB0, pB1, alB, l_reg, pa0, pa1, pa2, pa3); SBAR();
    if (j + 3 < NT) SLOAD(SE, (j + 3) * KVBLK); SBAR();
    pv_d0(o, vb0 + (int)SHM_V, pa0, pa1, pa2, pa3); partialSM(pA0, pA1, m_reg, mnA, alA);
    __syncthreads(); SWAIT(); SWRITE(1, SO);
    RESC(alA); __syncthreads();
  }
  SBAR(); qkt(pB0, pB1, (bf16_t*)((char*)K_lds + SHM_K), qr, r32, hi);
  finishSM(pA0, pA1, alA, l_reg, pa0, pa1, pa2, pa3); SBAR();
  pv_d0(o, vb0, pa0, pa1, pa2, pa3); partialSM(pB0, pB1, m_reg, mnB, alB);
  __syncthreads(); RESC(alB);
  finishSM(pB0, pB1, alB, l_reg, pa0, pa1, pa2, pa3); SBAR();
  pv_d0(o, vb0 + (int)SHM_V, pa0, pa1, pa2, pa3);
  if (hi == 0) li_l[r32] = l_reg; asm volatile("s_waitcnt lgkmcnt(0)" ::: "memory");
  float rli[16];
#pragma unroll
  for (int r = 0; r < 16; ++r) rli[r] = __builtin_amdgcn_rcpf(li_l[crow(r, hi)]);
  bf16_t* Ow = Ob + (long)(wid * QBLK) * LDO;
#pragma unroll
  for (int r = 0; r < 16; ++r) { int orow = crow(r, hi);
#pragma unroll
    for (int d0 = 0; d0 < 4; ++d0) Ow[(long)orow * LDO + d0 * 32 + r32] = (bf16_t)(cvt_pk_bf16(o[d0][r] * rli[r], 0.f) & 0xffffu); }
  __syncthreads();
#undef SLOAD
#undef SWRITE
#undef SWAIT
#undef RESC
}
}

__device__ __forceinline__ void transpose_item(const float* __restrict__ W, int N, bf16_t* __restrict__ WT, int ldt, int koff, LAS float* scr, int kb, int nb, int lane, int nperm) {
    const int k0 = 64 * kb, n0 = 64 * nb, lr = lane >> 4, lc = (lane & 15) * 4;
    const float* p = W + (size_t)(k0 + lr) * N + n0 + lc; const size_t step = (size_t)4 * N;
    f32x4 v[16];
#pragma unroll
    for (int i = 0; i < 16; ++i) { v[i] = *(const f32x4*)p; p += step; }
#pragma unroll
    for (int i = 0; i < 16; ++i) { LAS float* d = scr + (4 * i + lr) * 65 + lc; d[0] = v[i][0]; d[1] = v[i][1]; d[2] = v[i][2]; d[3] = v[i][3]; }
    asm volatile("s_waitcnt lgkmcnt(0)" ::: "memory");
    const int c = lane & 7;
#pragma unroll
    for (int j = 0; j < 8; ++j) { const int n = (lane >> 3) + 8 * j; const LAS float* s = scr + (8 * c) * 65 + n;
        u32x4 o; o.x = cvt_pk_bf16(s[0 * 65], s[1 * 65]); o.y = cvt_pk_bf16(s[2 * 65], s[3 * 65]); o.z = cvt_pk_bf16(s[4 * 65], s[5 * 65]); o.w = cvt_pk_bf16(s[6 * 65], s[7 * 65]);
        const int dn = (n0 < nperm) ? n0 + 8 * ((n & 31) >> 2) + 4 * (n >> 5) + (n & 3) : n0 + n;
        *(u32x4*)(WT + (size_t)dn * ldt + koff + k0 + 8 * c) = o; }
    asm volatile("s_waitcnt lgkmcnt(0)" ::: "memory");
}
__device__ __forceinline__ void rms_row_to_bf16(const float* __restrict__ xrow, const float* __restrict__ g, bf16_t* __restrict__ orow, int lane) {
    const f32x4* xr = (const f32x4*)xrow + lane; const f32x4* gr = (const f32x4*)g + lane;
    f32x4 v[8]; float s = 0.f;
#pragma unroll
    for (int j = 0; j < 8; ++j) { v[j] = xr[64 * j]; s += (v[j][0] * v[j][0] + v[j][1] * v[j][1]) + (v[j][2] * v[j][2] + v[j][3] * v[j][3]); }
    const float r = __builtin_amdgcn_rsqf(wave_sum(s) * (1.f / DM) + EPS);
    u32x2* o8 = (u32x2*)orow + lane;
#pragma unroll
    for (int j = 0; j < 8; ++j) { const f32x4 gg = gr[64 * j]; u32x2 w; w.x = cvt_pk_bf16(v[j][0] * r * gg[0], v[j][1] * r * gg[1]); w.y = cvt_pk_bf16(v[j][2] * r * gg[2], v[j][3] * r * gg[3]); o8[64 * j] = w; }
}
__device__ __forceinline__ void sincos_pos(float af, float& s, float& c) {
    const double a = (double)af;
    const double n = __builtin_rint(a * 0.63661977236758134308);
    const double r = __builtin_fma(-n, 1.57079632679489661923, a) - n * 6.12323399573676603587e-17;
    const double r2 = r * r;
    double ps = -2.5052108385441718775e-08; ps = ps * r2 + 2.7557319223985890653e-06; ps = ps * r2 - 1.9841269841269841270e-04; ps = ps * r2 + 8.3333333333333333333e-03; ps = ps * r2 - 1.6666666666666666667e-01;
    const double sr = r + r * r2 * ps;
    double pc = 2.0876756987868098979e-09; pc = pc * r2 - 2.7557319223985890653e-07; pc = pc * r2 + 2.4801587301587301587e-05; pc = pc * r2 - 1.3888888888888888889e-03; pc = pc * r2 + 4.1666666666666666667e-02; pc = pc * r2 - 0.5;
    const double cr = 1.0 + r2 * pc;
    const int q = ((int)n) & 3;
    const double ss = (q & 1) ? cr : sr, cc = (q & 1) ? sr : cr;
    s = (float)((q & 2) ? -ss : ss); c = (float)(((q + 1) & 2) ? -cc : cc);
}

constexpr int I_IN = (DM / 64) * (INW / 64), I_MKV = (DM / 64) * (1024 / 64), I_AO = (1024 / 64) * (DM / 64), I_GO = (512 / 64) * (DM / 64), I_MO = I_GO,
              I_OUT = (DM / 64) * (DM / 64), I_UP = (DM / 64) * (DFF / 64), I_DN = (DFF / 64) * (DM / 64);
constexpr int IT_EARLY = I_IN + I_MKV, NITEMS = IT_EARLY + I_AO + I_GO + I_MO + I_OUT + I_UP + I_DN, IT_P0 = IT_EARLY;

#define XB_TMO      128
#define XB_XCNT(j)  (256  + 64 * (j))
#define XB_XSUB(j)  (1280 + 64 * (j))
#define XB_XGEN(j)  (2304 + 64 * (j))
#define XB_TOP      3328
#define XB_TOPGEN   3392
#define XCD_BAR_WORDS 3456
#define XB_SPIN_CAP (1u << 18)
__device__ __forceinline__ unsigned xb_ld(unsigned* p)              { return __hip_atomic_load(p, __ATOMIC_RELAXED, __HIP_MEMORY_SCOPE_AGENT); }
__device__ __forceinline__ unsigned xb_add(unsigned* p, unsigned v) { return __hip_atomic_fetch_add(p, v, __ATOMIC_RELAXED, __HIP_MEMORY_SCOPE_AGENT); }
__device__ __forceinline__ unsigned xb_xcc_id() { return (unsigned)__builtin_amdgcn_s_getreg((3 << 11) | 20) & 0xFu; }
#define XB_SPIN(cond, bar) do { unsigned _sp = 0; while (cond) { __builtin_amdgcn_s_sleep(1); \
    if ((++_sp & 255u) == 0u) { if (xb_ld(&(bar)[XB_TMO])) break; if (_sp > XB_SPIN_CAP) { atomicAdd(&(bar)[XB_TMO], 1u); break; } } } } while (0)
struct XcdBarrier { unsigned* bar; unsigned x; volatile LAS unsigned* st; };
__device__ __forceinline__ XcdBarrier xcd_barrier_post(unsigned* bar, volatile LAS unsigned* st) {
    XcdBarrier b; b.bar = bar; b.x = xb_xcc_id(); b.st = st;
    if (threadIdx.x == 0) (void)xb_add(&bar[XB_XCNT(b.x)], 1u);
    return b;
}
__device__ __forceinline__ void xcd_barrier_complete(unsigned* bar, unsigned x, unsigned& nloc, unsigned& nx) {
    const unsigned G = gridDim.x * gridDim.y * gridDim.z;
    unsigned sum, cnt, mine, sp = 0u;
    for (;;) {
        sum = 0u; cnt = 0u; mine = 0u;
#pragma unroll
        for (unsigned j = 0; j < 16; ++j) { const unsigned c = xb_ld(&bar[XB_XCNT(j)]); sum += c; cnt += (c > 0u) ? 1u : 0u; mine = (j == x) ? c : mine; }
        if (sum == G) break;
        __builtin_amdgcn_s_sleep(1);
        if ((++sp & 255u) == 0u) { if (xb_ld(&bar[XB_TMO])) break; if (sp > XB_SPIN_CAP) { atomicAdd(&bar[XB_TMO], 1u); break; } }
    }
    nloc = mine > 0u ? mine : 1u; nx = cnt > 0u ? cnt : 1u;
}
__device__ __forceinline__ void xcd_barrier(const XcdBarrier& b, const int wave) {
    asm volatile("s_waitcnt vmcnt(0)" ::: "memory");
    __syncthreads();
    if (wave == 0 && __builtin_amdgcn_mbcnt_lo(~0u, 0u) == 0u) {
        unsigned* bar = b.bar;
        __builtin_amdgcn_s_waitcnt(0);
        unsigned nloc = b.st[0], nx = b.st[1];
        if (nloc == 0u) { xcd_barrier_complete(bar, b.x, nloc, nx); b.st[0] = nloc; b.st[1] = nx; }
        const unsigned old = xb_add(&bar[XB_XSUB(b.x)], 1u);
        const unsigned gen = old / nloc;
        if (old + 1u == (gen + 1u) * nloc) {
            __builtin_amdgcn_fence(__ATOMIC_RELEASE, "agent");
            asm volatile("s_waitcnt vmcnt(0)" ::: "memory");
            const unsigned og = xb_add(&bar[XB_TOP], 1u);
            const unsigned tg = og / nx;
            if (og + 1u == (tg + 1u) * nx) xb_add(&bar[XB_TOPGEN], 1u);
            else XB_SPIN(xb_ld(&bar[XB_TOPGEN]) == tg, bar);
            __builtin_amdgcn_fence(__ATOMIC_ACQUIRE, "agent");
            xb_add(&bar[XB_XGEN(b.x)], 1u);
            asm volatile("s_waitcnt vmcnt(0)" ::: "memory");
        } else {
            XB_SPIN(xb_ld(&bar[XB_XGEN(b.x)]) == gen, bar);
            __builtin_amdgcn_fence(__ATOMIC_ACQUIRE, "agent");
            asm volatile("s_waitcnt vmcnt(0)" ::: "memory");
        }
    }
    __syncthreads();
}

__global__ void __launch_bounds__(512, 1) fwd_megakernel(Args a_unused) {
    extern __shared__ __attribute__((aligned(16))) unsigned char lds_raw[];
    LAS unsigned char* lds = (LAS unsigned char*)lds_raw;
    const int tid0 = threadIdx.x, wave = __builtin_amdgcn_readfirstlane(tid0 >> 6);
    const int G = gridDim.x, bx = blockIdx.x;
    const int gw = bx * 8 + wave, NGW = G * 8;
#define a (*ap)
#define PHASE_ENTER() int tid_; asm volatile("v_mbcnt_lo_u32_b32 %0, -1, 0\n\tv_mbcnt_hi_u32_b32 %0, -1, %0\n\tv_lshl_add_u32 %0, %1, 6, %0" : "=&v"(tid_) : "s"(wave));   \
    const int tid = tid_ & 511, lane = tid & 63; (void)lane; \
    CArgs* ap = ARGP(); unsigned char* ws = a.ws; \
    bf16_t* WdownT = (bf16_t*)(ws + WS_WDOWN); bf16_t* WupT = (bf16_t*)(ws + WS_WUP); bf16_t* WoutT = (bf16_t*)(ws + WS_WOUT); bf16_t* WcatT = (bf16_t*)(ws + WS_WCAT); \
    bf16_t* Hb = (bf16_t*)(ws + WS_H); bf16_t* XCAT = Hb; bf16_t* A2 = Hb; \
    float* SSVP = (float*)(ws + WS_SMALL + SM_SSVP); float* SSQ = (float*)(ws + WS_SMALL + SM_SSQ); float* CS = (float*)(ws + WS_SMALL + SM_CS); bf16_t* MEMN = (bf16_t*)(ws + WS_SMALL + SM_MEMN); \
    bf16_t* KMb = (bf16_t*)(ws + WS_SMALL + SM_KMB); bf16_t* VMb = (bf16_t*)(ws + WS_SMALL + SM_VMB); \
    bf16_t* WinT = (bf16_t*)(ws + WS_R0); bf16_t* Qb = (bf16_t*)((unsigned char*)a.out + R0_QB); bf16_t* Kb = (bf16_t*)((unsigned char*)a.out + R0_KB); bf16_t* GVb = (bf16_t*)((unsigned char*)a.out + R0_VN); \
    bf16_t* MERGED = (bf16_t*)(ws + WS_R0); bf16_t* U2 = (bf16_t*)(ws + WS_R0); \
    bf16_t* WmkvT = (bf16_t*)(ws + WS_WMKV); bf16_t* GATES = (bf16_t*)(ws + WS_GATES); \
    bf16_t* Vb = (bf16_t*)(ws + WS_VB); bf16_t* Ub = (bf16_t*)(ws + WS_UB); \
    LAS float* xch = (LAS float*)(lds + LDS_XCH_OFF);
    const int lo = ((CArgs*)__builtin_amdgcn_kernarg_segment_ptr())->ph_lo, hi = ((CArgs*)__builtin_amdgcn_kernarg_segment_ptr())->ph_hi;
#ifndef PHASE_MASK
#define PHASE_MASK 0xff
#endif
#define IN(k) (((PHASE_MASK >> (k)) & 1) && lo <= (k) && (k) < hi)
    volatile LAS unsigned* xb_st = (volatile LAS unsigned*)(lds + LDS_ST_OFF);
    if (tid0 == 0) { xb_st[0] = 0u; xb_st[1] = 0u; }
    __syncthreads();
    const XcdBarrier xbar = xcd_barrier_post((unsigned*)(((CArgs*)__builtin_amdgcn_kernarg_segment_ptr())->ws + WS_SMALL + SM_BAR), xb_st);
#define SYNC(k) do { if (IN(k)) xcd_barrier(xbar, wave); } while (0)

    if (IN(0)) { PHASE_ENTER();
        for (int i = bx * 512 + tid; i < S * 4; i += G * 512) ((f32x4*)SSQ)[i] = (f32x4){127.999872f, 127.999872f, 127.999872f, 127.999872f};
        for (int i = bx * 512 + tid; i < 128 * 32; i += G * 512) {
            const int pos = i >> 5, f = i & 31; float sn, cs; sincos_pos((float)pos * __builtin_amdgcn_exp2f((float)f * (-13.287712379549449f / 32.0f)), sn, cs);
            CS[2 * i] = cs; CS[2 * i + 1] = sn; }
        LAS float* scr = (LAS float*)(lds + wave * 16640);
#define TRANSPOSE_ITEMS(IT0, IT1, W0, NW_) \
        for (int it = (IT0) + (W0); it < (IT1); it += (NW_)) { \
            int r = it; const float* W; bf16_t* WT; int N, ldt, koff, nperm = 0; \
            if (r < I_IN) { W = a.w_in; N = INW; WT = WinT; ldt = DM; koff = 0; nperm = 1280; } \
            else if ((r -= I_IN) < I_MKV) { W = a.w_mem_kv; N = 1024; WT = WmkvT; ldt = DM; koff = 0; } \
            else if ((r -= I_MKV) < I_AO) { W = a.w_attn_o; N = DM; WT = WcatT; ldt = DM; koff = 0; } \
            else if ((r -= I_AO) < I_GO) { W = a.w_gmlp_o; N = DM; WT = WcatT; ldt = DM; koff = 1024; } \
            else if ((r -= I_GO) < I_MO) { W = a.w_mem_o; N = DM; WT = WcatT; ldt = DM; koff = 1536; } \
            else if ((r -= I_MO) < I_OUT) { W = a.w_out; N = DM; WT = WoutT; ldt = DM; koff = 0; } \
            else if ((r -= I_OUT) < I_UP) { W = a.w_ffn_up; N = DFF; WT = WupT; ldt = DM; koff = 0; } \
            else { r -= I_UP; W = a.w_ffn_down; N = DM; WT = WdownT; ldt = DFF; koff = 0; } \
              \
            const int nbk = N >> 6, g8 = 8 * nbk, kb8 = r / g8, rem = r - kb8 * g8; \
            transpose_item(W, N, WT, ldt, koff, scr, kb8 * 8 + (rem & 7), rem >> 3, lane, nperm); \
        }
        TRANSPOSE_ITEMS(0, IT_P0, gw, NGW)
        for (int m = gw; m < S + MEMT; m += NGW) {
            if (m < S) rms_row_to_bf16(a.x + (size_t)m * DM, a.norm_mix, Hb + (size_t)m * DM, lane);
            else rms_row_to_bf16(a.mem + (size_t)(m - S) * DM, a.mem_norm, MEMN + (size_t)(m - S) * DM, lane);
        }
        __syncthreads();
    }
    SYNC(0);

    if (IN(1)) { PHASE_ENTER();
        { pg8::Gemm g{Hb, WinT, DM}; pg8::InProjOrder So; So.init(S, INW, DM, G, bx);
          pg8::EpiInProj E{xch};
          pg8::gemm_phase(lds, g, So, E, tid); }
        { pg8::Gemm g{MEMN, WmkvT, DM}; pg8::StaticOrder So; So.init(MEMT, 1024, DM, G, (bx + G / 2) % G);
          pg8::EpiMemKV E{xch};
          pg8::gemm_phase(lds, g, So, E, tid); }
        if (bx >= G / 2 + 4) {
            LAS float* scr = (LAS float*)(lds + wave * 16640);
            TRANSPOSE_ITEMS(IT_P0, NITEMS, (bx - G / 2 - 4) * 8 + wave, (G - G / 2 - 4) * 8)
            __syncthreads();
        }
    }
    SYNC(1);


    if (IN(3)) { PHASE_ENTER();
#ifndef P3_MASK
#define P3_MASK 7
#endif
        if (P3_MASK & 1) for (int w = bx; w < 384; w += G) {
            const bool self = w < 256; const int h = self ? (w & 7) : (w & 3), qb = self ? (w >> 3) : ((w - 256) >> 2);
            const bf16_t* Qp = Qb + (size_t)qb * 256 * 1536 + (self ? h * 128 : 1024 + h * 128);
            const bf16_t* Kp = self ? Kb + (h >> 2) * 128 : KMb + (size_t)(h >> 1) * 65536 + (h & 1) * 128;
            const bf16_t* Vp = self ? Vb + (h >> 2) * 128 : VMb + (size_t)(h >> 1) * 65536 + (h & 1) * 128;
            bf16_t* Op = XCAT + (size_t)qb * 256 * 2048 + (self ? h * 128 : 1536 + h * 128);
            att::attn_dense_body<1536, 256, 2048>(Qp, Kp, Vp, Op, self ? S : MEMT, (char*)lds_raw, SSQ + (size_t)qb * 256 * 16 + (self ? h : 8 + h), tid);
        }
        if ((P3_MASK & 4) && bx >= G / 2) for (int w = bx - G / 2; w < 256; w += G - G / 2) {
            const int c = w >> 2, g = w & 3; LAS bf16_t* vt = (LAS bf16_t*)lds; constexpr int PITCH = 144;
            const int fr = lane & 15, fq = lane >> 4, i0 = wave * 16;
            {
                u32x4 vst[4];
#pragma unroll
                for (int q = 0; q < 4; ++q) { const int ch = tid + q * 512, jr = ch >> 4, dc = (ch & 15) * 8; vst[q] = *(const u32x4*)(GVb + (size_t)(c * 128 + jr) * 512 + g * 128 + dc); }
                const float* wsr = a.w_spatial + (size_t)g * 128 * 128 + (size_t)(i0 + fr) * 128 + fq * 8;
                f32x4 wv[4][2], sv[4][2];
#pragma unroll
                for (int ks = 0; ks < 4; ++ks) { wv[ks][0] = *(const f32x4*)(wsr + ks * 32); wv[ks][1] = *(const f32x4*)(wsr + ks * 32 + 4);
                    const float* sp = SSVP + ((size_t)c * 128 + ks * 32 + fq * 8) * 2; const f32x4 p0 = *(const f32x4*)sp, p1 = *(const f32x4*)(sp + 4), p2 = *(const f32x4*)(sp + 8), p3 = *(const f32x4*)(sp + 12);
                    sv[ks][0] = (f32x4){p0[0] + p0[1], p0[2] + p0[3], p1[0] + p1[1], p1[2] + p1[3]}; sv[ks][1] = (f32x4){p2[0] + p2[1], p2[2] + p2[3], p3[0] + p3[1], p3[2] + p3[3]}; }
                const size_t t = (size_t)c * 128 + i0 + fr;
                const float bs = a.b_spatial[g * 128 + i0 + fr];
                u32x2 ubv[8]; f32x4 sg[8];
#pragma unroll
                for (int n = 0; n < 8; ++n) { ubv[n] = *(const u32x2*)(Ub + t * 512 + g * 128 + n * 16 + fq * 4); sg[n] = *(const f32x4*)(a.sgu_norm + g * 128 + n * 16 + fq * 4); }
#pragma unroll
                for (int q = 0; q < 4; ++q) { const int ch = tid + q * 512, jr = ch >> 4, dc = (ch & 15) * 8; LAS bf16_t* p = vt + dc * PITCH + jr;
                    p[0 * PITCH] = (bf16_t)(vst[q].x & 0xffffu); p[1 * PITCH] = (bf16_t)(vst[q].x >> 16); p[2 * PITCH] = (bf16_t)(vst[q].y & 0xffffu); p[3 * PITCH] = (bf16_t)(vst[q].y >> 16);
                    p[4 * PITCH] = (bf16_t)(vst[q].z & 0xffffu); p[5 * PITCH] = (bf16_t)(vst[q].z >> 16); p[6 * PITCH] = (bf16_t)(vst[q].w & 0xffffu); p[7 * PITCH] = (bf16_t)(vst[q].w >> 16); }
                __syncthreads();
                f32x4 acc[8];
#pragma unroll
                for (int n = 0; n < 8; ++n) acc[n] = (f32x4){0.f, 0.f, 0.f, 0.f};
#pragma unroll
                for (int ks = 0; ks < 4; ++ks) {
                    f32x4 w0 = wv[ks][0], w1 = wv[ks][1];
#pragma unroll
                    for (int e = 0; e < 4; ++e) { w0[e] *= __builtin_amdgcn_rsqf(sv[ks][0][e] * (1.f / 512.f) + EPS); w1[e] *= __builtin_amdgcn_rsqf(sv[ks][1][e] * (1.f / 512.f) + EPS); }
                    const u32x4 aw = pg8::pack8(w0, w1); const bf16x8 wf = *reinterpret_cast<const bf16x8*>(&aw);
#pragma unroll
                    for (int n = 0; n < 8; ++n) { const bf16x8 vf = *(const LAS bf16x8*)(vt + (n * 16 + fr) * PITCH + ks * 32 + fq * 8);
                        acc[n] = __builtin_amdgcn_mfma_f32_16x16x32_bf16(vf, wf, acc[n], 0, 0, 0); }
                }
#pragma unroll
                for (int n = 0; n < 8; ++n) { f32x4 o;
                    o[0] = __uint_as_float(ubv[n].x << 16) * (acc[n][0] * sg[n][0] + bs); o[1] = __uint_as_float(ubv[n].x & 0xffff0000u) * (acc[n][1] * sg[n][1] + bs);
                    o[2] = __uint_as_float(ubv[n].y << 16) * (acc[n][2] * sg[n][2] + bs); o[3] = __uint_as_float(ubv[n].y & 0xffff0000u) * (acc[n][3] * sg[n][3] + bs);
                    *(u32x2*)(XCAT + t * 2048 + 1024 + g * 128 + n * 16 + fq * 4) = pg8::pack4(o); }
                __syncthreads();
            }
        }
    }
    SYNC(3);

    if (IN(4)) { PHASE_ENTER();
        pg8::Gemm g{XCAT, WcatT, DM}; pg8::BranchOrder So; So.init(S, DM, G, bx);
        pg8::EpiBranch E{};
        pg8::gemm_phase(lds, g, So, E, tid);
    }
    SYNC(4);

    if (IN(5)) { PHASE_ENTER();
        pg8::Gemm g{MERGED, WoutT, DM}; pg8::StaticOrder So; So.init(S, DM, DM, G, bx);
        pg8::EpiOut E; E.xch = xch; { pg8::Unit u0; E.gpn = So.next(0, u0) ? u0.pn : -1; const int wid_ = tid >> 6; const int c0_ = (E.gpn < 0 ? 0 : E.gpn) * 256 + (wid_ & 3) * 32 + 8 * (lane >> 4);
#pragma unroll
            for (int bj = 0; bj < 2; ++bj) { E.g[bj][0] = *(const f32x4*)(a.norm_ffn + c0_ + bj * 128); E.g[bj][1] = *(const f32x4*)(a.norm_ffn + c0_ + bj * 128 + 4); } }
        pg8::gemm_phase(lds, g, So, E, tid, pg8::ResidInit{0});
    }
    SYNC(5);

    if (IN(6)) { PHASE_ENTER();
        pg8::Gemm g{A2, WupT, DM}; pg8::StaticOrder So; So.init(S, DFF, DM, G, bx);
        pg8::EpiUp E; { pg8::Unit u0; E.pm0 = So.next(0, u0) ? u0.pm : -1;
            const int wid_ = tid >> 6; pg8::EpiUp::load_rs((const float*)(ws + WS_SMALL + SM_ROWSSP), (E.pm0 < 0 ? 0 : E.pm0) * 256 + (wid_ >> 2) * 64 + (lane & 15), E.rs0); }
        pg8::gemm_phase(lds, g, So, E, tid);
    }
    SYNC(6);

    if (IN(7)) { PHASE_ENTER();
        pg8::Gemm g{U2, WdownT, DFF}; pg8::StaticOrder So; So.init(S, DM, DFF, G, bx);
        pg8::EpiDown E{};
        pg8::gemm_phase(lds, g, So, E, tid, pg8::ResidInit{1});
    }
#undef IN
#undef SYNC
#undef a
}

extern "C" void kernel_launch(void* const* d_in, const int* in_sizes, int n_in, void* d_out, int out_size, void* d_ws, size_t ws_size, hipStream_t stream) {
    static int grid = 0;
    if (grid == 0) {
        if (n_in != 20 || in_sizes[0] != S * DM || out_size != S * DM || ws_size < WS_END) {
            fprintf(stderr, "kernel_launch: unexpected shapes: n_in %d in0 %d out %d ws %zu (need %zu)\n", n_in, n_in > 0 ? in_sizes[0] : -1, out_size, ws_size, (size_t)WS_END); grid = -1; return; }
        int dev = 0, cus = 0, per_cu = 0;
        hipGetDevice(&dev); hipDeviceGetAttribute(&cus, hipDeviceAttributeMultiprocessorCount, dev);
        if (hipFuncSetAttribute((const void*)fwd_megakernel, hipFuncAttributeMaxDynamicSharedMemorySize, LDS_BYTES) != hipSuccess) { fprintf(stderr, "kernel_launch: hipFuncSetAttribute failed\n"); grid = -1; return; }
        if (hipOccupancyMaxActiveBlocksPerMultiprocessor(&per_cu, (const void*)fwd_megakernel, 512, LDS_BYTES) != hipSuccess || per_cu < 1) { fprintf(stderr, "kernel_launch: occupancy query failed (%d)\n", per_cu); grid = -1; return; }
        grid = cus;
        fprintf(stderr, "kernel_launch: cus %d per_cu %d grid %d\n", cus, per_cu, grid);
    }
    if (grid < 0) return;
    Args a{};
    const float** f = (const float**)&a;
    for (int i = 0; i < 20; ++i) f[i] = (const float*)d_in[i];
    a.out = (float*)d_out; a.ws = (unsigned char*)d_ws;
#ifndef PROBE_A
#define PROBE_A 8
#define PROBE_B 8
#endif
    hipError_t e = hipSuccess;
    for (int li = 0; li < (PROBE_A < 8 || PROBE_B < 8 ? 2 : 1); ++li) {
        a.ph_lo = li == 0 ? 0 : PROBE_B; a.ph_hi = li == 0 ? PROBE_A : 8;
        if (hipMemsetAsync((char*)d_ws + WS_SMALL + SM_BAR, 0, XCD_BAR_WORDS * 4, stream) != hipSuccess) { fprintf(stderr, "kernel_launch: memset failed\n"); return; }
        void* args[] = {&a};
        e = hipLaunchCooperativeKernel((const void*)fwd_megakernel, dim3(grid), dim3(512), args, LDS_BYTES, stream);
        if (e != hipSuccess) break;
    }
    if (e != hipSuccess) fprintf(stderr, "kernel_launch: cooperative launch failed: %s (grid %d)\n", hipGetErrorString(e), grid);
}
```

```cpp
#include <hip/hip_runtime.h>
#include <hip/hip_cooperative_groups.h>
#include <cstdio>
#include <cstdint>
namespace cg = cooperative_groups;

#define LAS __attribute__((address_space(3)))
typedef unsigned short bf16_t;
typedef short bf16x8 __attribute__((ext_vector_type(8)));
typedef short s16x4 __attribute__((ext_vector_type(4)));
typedef float f32x4 __attribute__((ext_vector_type(4)));
typedef float f32x8 __attribute__((ext_vector_type(8)));
typedef float f32x16 __attribute__((ext_vector_type(16)));
typedef unsigned u32x4 __attribute__((ext_vector_type(4)));
typedef unsigned u32x2 __attribute__((ext_vector_type(2)));

constexpr int S = 8192, DM = 2048, INW = 9216, DFF = 8192, MEMT = 256;
constexpr float EPS = 1e-6f;
constexpr size_t MiB = 1024ull * 1024ull;
constexpr size_t WS_WDOWN = 0 * MiB, WS_WUP = 32 * MiB, WS_WOUT = 64 * MiB, WS_WCAT = 72 * MiB, WS_H = 80 * MiB  ,
                 WS_SMALL = 112 * MiB, WS_R0 = 116 * MiB  , WS_WMKV = 152 * MiB, WS_GATES = 156 * MiB,
                 WS_QMRAW = 252 * MiB, WS_VB = 268 * MiB, WS_UB = 272 * MiB, WS_END = 280 * MiB;
constexpr size_t SM_ROWSS = 0, SM_SSV = 32 * 1024, SM_MEMN = 64 * 1024, SM_KMRAW = SM_MEMN + 1 * MiB, SM_KMB = SM_KMRAW + 512 * 1024, SM_VMB = SM_KMB + 256 * 1024, SM_BAR = 2560 * 1024  , SM_CS = SM_BAR + 64 * 1024  , SM_SSQ = 3072 * 1024  ,
                 SM_ROWSSP = 3584 * 1024  , SM_SSVP = 3840 * 1024  ;
constexpr size_t R0_QB = 0  , R0_KB = 24 * MiB, R0_VN = 28 * MiB;
constexpr int LDS_ST_OFF = 133120, LDS_XCH_OFF = 133136  , LDS_BYTES = 133136 + 8192;

struct Args {
    const float *x, *mem, *norm_mix, *w_in, *q_norm, *k_norm, *sgu_norm, *w_spatial, *b_spatial, *mem_norm, *w_mem_kv, *mq_norm, *mk_norm,
                *w_attn_o, *w_gmlp_o, *w_mem_o, *w_out, *norm_ffn, *w_ffn_up, *w_ffn_down;
    float* out; unsigned char* ws; int ph_lo, ph_hi;
};
typedef __attribute__((address_space(4))) const Args CArgs;
#define ARGP() ({ CArgs* p_ = (CArgs*)__builtin_amdgcn_kernarg_segment_ptr(); asm volatile("" : "+s"(p_)); p_; })

__device__ __forceinline__ unsigned cvt_pk_bf16(float lo, float hi) { unsigned r; asm volatile("v_cvt_pk_bf16_f32 %0, %1, %2" : "=v"(r) : "v"(lo), "v"(hi)); return r; }
__device__ __forceinline__ float wave_sum(float v) {
#pragma unroll
    for (int o = 1; o < 64; o <<= 1) v += __shfl_xor(v, o);
    return v;
}
__device__ __forceinline__ float gelu_tanh(float x) {
    const float e = __builtin_amdgcn_exp2f(x * (-2.302208198f - 0.10294324f * x * x));
    return x * __builtin_amdgcn_rcpf(1.0f + e);
}
__device__ __forceinline__ float sigmoidf_(float z) { return __builtin_amdgcn_rcpf(1.0f + __builtin_amdgcn_exp2f(-1.4426950408889634f * z)); }

namespace pg8 {
constexpr int BM = 256, BK = 64, HALF = 128, HTB = HALF * BK * 2, STAGE_BYTES = 8 * HTB, NXCD = 8, WGM = 8;
__device__ __forceinline__ int lds_byte(int r, int c) { const int st = (r >> 4) * 2 + (c >> 5), rr = r & 15, cc = c & 31, ob = rr * 64 + cc * 2; return st * 1024 + (ob ^ (((ob >> 9) & 1) << 5)); }
__device__ __forceinline__ void stage_rc(int b, int& R, int& C) { const int st = b / 1024, sb = b % 1024, swz = sb ^ (((sb >> 9) & 1) << 5); R = (st >> 1) * 16 + swz / 64; C = (st & 1) * 32 + (swz % 64) / 2; }
__device__ __forceinline__ int perm32(int rho) { const int n = rho >> 4, i = rho & 15; return 8 * (i >> 2) + 4 * n + (i & 3); }

struct Unit { int pm, pn, kb, nt, tag, keep; };
struct Gemm { const bf16_t* A; const bf16_t* Bt; int K; };

__device__ __forceinline__ void map_tile(long L, int nM, int nN, int& pm, int& pn) {
    const int nwg = nM * nN; int wgid = (int)L;
    { const int q = nwg / NXCD, r = nwg % NXCD, xcd = wgid % NXCD, off = wgid / NXCD; wgid = (xcd < r ? xcd * (q + 1) : r * (q + 1) + (xcd - r) * q) + off; }
    const int nig = WGM * nN, gid = wgid / nig, fm = gid * WGM, gsz = (nM - fm) < WGM ? (nM - fm) : WGM;
    pm = fm + ((wgid % nig) % gsz); pn = (wgid % nig) / gsz;
}
struct StaticOrder {
    int nM, nN, nwg, G, c, nt;
    __device__ void init(int M, int N, int K, int G_, int c_) { nM = M / BM; nN = N / BM; nwg = nM * nN; G = G_; c = c_; nt = K / BK; }
    __device__ bool next(int i, Unit& u) const {
        const long L = (long)i * G + c; if (L >= nwg) return false;
        map_tile(L, nM, nN, u.pm, u.pn); u.kb = 0; u.nt = nt; u.tag = 0; u.keep = 0; return true;
    }
};
struct InProjOrder : StaticOrder {
    __device__ bool next(int i, Unit& u) const {
        if (!StaticOrder::next(i, u)) return false;
        const unsigned long long T0 = 0x34c0c11c608014bull, T1 = 0x5d65544d24503ceull, T2 = 0x75c6da288658244ull, T3 = 0x8e28607deull;
        const int k = u.pn / 10, j = u.pn - 10 * k; const unsigned long long t = k == 0 ? T0 : (k == 1 ? T1 : (k == 2 ? T2 : T3));
        u.pn = (int)((t >> (6 * j)) & 63ull); return true;
    }
};
struct BranchOrder {
    int nM, nN, nwg, G, c;
    __device__ void init(int M, int N, int G_, int c_) { nM = M / BM; nN = N / BM; nwg = nM * nN; G = G_; c = c_; }
    __device__ bool next(int i, Unit& u) const {
        const int ti = i / 3, br = i - 3 * ti; const long L = (long)ti * G + c; if (L >= nwg) return false;
        map_tile(L, nM, nN, u.pm, u.pn); u.kb = (br == 0 ? 0 : (br == 1 ? 1024 : 1536)) * 2; u.nt = (br == 0 ? 16 : 8); u.tag = br; u.keep = br < 2; return true;
    }
};

struct ZeroInit { __device__ __forceinline__ void operator()(f32x4 (&acc)[2][2][4][2], const Unit&, int, int, int, int) const {
#pragma unroll
    for (int a = 0; a < 2; ++a)
#pragma unroll
        for (int b = 0; b < 2; ++b)
#pragma unroll
            for (int m = 0; m < 4; ++m)
#pragma unroll
                for (int n = 0; n < 2; ++n) acc[a][b][m][n] = (f32x4){0.f, 0.f, 0.f, 0.f}; } };
template <class Epi, class Sched, class Init = ZeroInit>
__device__ __forceinline__ void gemm_phase(LAS unsigned char* lds, const Gemm g, const Sched& S, const Epi& E, const int tid, const Init& I = Init()) {
    const int wid = __builtin_amdgcn_readfirstlane(tid >> 6), lane = tid & 63, wr = wid >> 2, wc = wid & 3, fr = lane & 15, fq = lane >> 4;
    const int K = g.K;
    unsigned voffA[2], voffB[2];
#pragma unroll
    for (int i = 0; i < 2; ++i) { int R, C; stage_rc(tid * 16 + i * 8192, R, C); const int Rb = (R & ~31) + perm32(R & 31);
        voffA[i] = (unsigned)(R * K + C) * 2u; voffB[i] = (unsigned)(Rb * K + C) * 2u; }
    const size_t kstep = (size_t)(BK * 2);
    const size_t hstep = (size_t)HALF * K * 2;
    const size_t tstep = 2 * hstep;
    const unsigned ldsw = (unsigned)wid * 1024u;
    const int aoff = lds_byte(wr * 64 + fr, fq * 8), boff = lds_byte(wc * 32 + fr, fq * 8);
#define PG8_SA(b, h) (((b) * 2 + (h)) * HTB)
#define PG8_SB(b, h) ((4 + (b) * 2 + (h)) * HTB)
#define PG8_STAGE(bufoff, gbase, voff) do { _Pragma("unroll") for (int _i = 0; _i < 2; ++_i) \
        __builtin_amdgcn_global_load_lds((const unsigned*)((const char*)(gbase) + (voff)[_i]), (LAS unsigned*)(lds + (bufoff) + ldsw + _i * 8192), 16, 0, 0); } while (0)
#define PG8_LDA(dst, b, h) do { _Pragma("unroll") for (int m = 0; m < 4; ++m) _Pragma("unroll") for (int k = 0; k < 2; ++k) dst[m][k] = *(const LAS bf16x8*)(lds + PG8_SA(b, h) + aoff + m * 2048 + k * 1024); } while (0)
#define PG8_LDB(dst, b, h) do { _Pragma("unroll") for (int n = 0; n < 2; ++n) _Pragma("unroll") for (int k = 0; k < 2; ++k) dst[n][k] = *(const LAS bf16x8*)(lds + PG8_SB(b, h) + boff + n * 2048 + k * 1024); } while (0)
#define PG8_MMA(ai, bj, At, Bt) do { __builtin_amdgcn_s_setprio(1); _Pragma("unroll") for (int m = 0; m < 4; ++m) _Pragma("unroll") for (int n = 0; n < 2; ++n) _Pragma("unroll") for (int k = 0; k < 2; ++k) \
        acc[ai][bj][m][n] = __builtin_amdgcn_mfma_f32_16x16x32_bf16(Bt[n][k], At[m][k], acc[ai][bj][m][n], 0, 0, 0); __builtin_amdgcn_s_setprio(0); } while (0)
#define PG8_WAIT_V(n) asm volatile("s_waitcnt vmcnt(" #n ")" ::: "memory")
#define PG8_WAIT_L(n) asm volatile("s_waitcnt lgkmcnt(" #n ")" ::: "memory")
#define PG8_BAR __builtin_amdgcn_s_barrier()
#define PG8_SCHED __builtin_amdgcn_sched_barrier(0)
    Unit cur, nxt; int ui = 0;
    if (!S.next(0, cur)) return;
    f32x4 acc[2][2][4][2];
    I(acc, cur, wr, wc, fr, fq);
    bf16x8 At[4][2], B0[2][2], B1[2][2];
    const char* cA = (const char*)g.A + (size_t)cur.pm * tstep + cur.kb; const char* cB = (const char*)g.Bt + (size_t)cur.pn * tstep + cur.kb;
    PG8_STAGE(PG8_SB(0, 0), cB, voffB); PG8_STAGE(PG8_SA(0, 0), cA, voffA); PG8_STAGE(PG8_SB(0, 1), cB + hstep, voffB); PG8_STAGE(PG8_SA(0, 1), cA + hstep, voffA);
    if (wr == 1) PG8_BAR;
    PG8_WAIT_V(4); PG8_BAR;
    PG8_STAGE(PG8_SB(1, 0), cB + kstep, voffB); PG8_STAGE(PG8_SA(1, 0), cA + kstep, voffA); PG8_STAGE(PG8_SB(1, 1), cB + hstep + kstep, voffB);
    PG8_WAIT_V(6); PG8_BAR;
    for (;;) {
        const bool has_next = S.next(ui + 1, nxt);
        const char* nA = has_next ? (const char*)g.A + (size_t)nxt.pm * tstep + nxt.kb : cA; const char* nB = has_next ? (const char*)g.Bt + (size_t)nxt.pn * tstep + nxt.kb : cB;
        const int nt = cur.nt;
        for (int t = 0; t < nt; t += 2) {
            const bool last = (t == nt - 2);
            const char* a1 = cA + (size_t)(t + 1) * kstep;
            const char* a2 = last ? nA : cA + (size_t)(t + 2) * kstep; const char* b2 = last ? nB : cB + (size_t)(t + 2) * kstep;
            const char* a3 = a2 + kstep; const char* b3 = b2 + kstep;
            PG8_LDB(B0, 0, 0); PG8_SCHED; PG8_LDA(At, 0, 0); PG8_STAGE(PG8_SA(1, 1), a1 + hstep, voffA);
            PG8_WAIT_L(8); PG8_BAR; PG8_WAIT_L(0); PG8_MMA(0, 0, At, B0); PG8_BAR; PG8_SCHED;
            PG8_LDB(B1, 0, 1); PG8_STAGE(PG8_SB(0, 0), b2, voffB);
            PG8_BAR; PG8_WAIT_L(0); PG8_MMA(0, 1, At, B1); PG8_BAR;
            PG8_LDA(At, 0, 1); PG8_STAGE(PG8_SA(0, 0), a2, voffA);
            PG8_BAR; PG8_WAIT_L(0); PG8_MMA(1, 0, At, B0); PG8_BAR; PG8_SCHED;
            PG8_STAGE(PG8_SB(0, 1), b2 + hstep, voffB);
            PG8_WAIT_V(6); PG8_BAR; PG8_MMA(1, 1, At, B1); PG8_BAR;
            PG8_LDB(B0, 1, 0); PG8_SCHED; PG8_LDA(At, 1, 0); PG8_STAGE(PG8_SA(0, 1), a2 + hstep, voffA);
            PG8_WAIT_L(8); PG8_BAR; PG8_WAIT_L(0); PG8_MMA(0, 0, At, B0); PG8_BAR; PG8_SCHED;
            PG8_LDB(B1, 1, 1); PG8_STAGE(PG8_SB(1, 0), b3, voffB);
            PG8_BAR; PG8_WAIT_L(0); PG8_MMA(0, 1, At, B1); PG8_BAR;
            PG8_LDA(At, 1, 1); PG8_STAGE(PG8_SA(1, 0), a3, voffA);
            PG8_BAR; PG8_WAIT_L(0); PG8_MMA(1, 0, At, B0); PG8_BAR; PG8_SCHED;
            PG8_STAGE(PG8_SB(1, 1), b3 + hstep, voffB);
            PG8_WAIT_V(6); PG8_BAR; PG8_MMA(1, 1, At, B1); PG8_BAR;
        }
        E(acc, cur, wr, wc, fr, fq);
        if (!has_next) break;
        if (!cur.keep) I(acc, nxt, wr, wc, fr, fq);
        cur = nxt; cA = nA; cB = nB; ++ui;
    }
    PG8_WAIT_V(0);
    if (wr == 0) PG8_BAR;
    PG8_BAR;
#undef PG8_SA
#undef PG8_SB
#undef PG8_STAGE
#undef PG8_LDA
#undef PG8_LDB
#undef PG8_MMA
#undef PG8_WAIT_V
#undef PG8_WAIT_L
#undef PG8_BAR
#undef PG8_SCHED
}

__device__ __forceinline__ u32x4 pack8(f32x4 v0, f32x4 v1) { u32x4 w; w.x = cvt_pk_bf16(v0[0], v0[1]); w.y = cvt_pk_bf16(v0[2], v0[3]); w.z = cvt_pk_bf16(v1[0], v1[1]); w.w = cvt_pk_bf16(v1[2], v1[3]); return w; }

__device__ __forceinline__ u32x2 pack4(f32x4 v) { u32x2 w; w.x = cvt_pk_bf16(v[0], v[1]); w.y = cvt_pk_bf16(v[2], v[3]); return w; }
__device__ __forceinline__ float sumsq8(f32x4 a, f32x4 b) { return (a[0] * a[0] + a[1] * a[1]) + (a[2] * a[2] + a[3] * a[3]) + (b[0] * b[0] + b[1] * b[1]) + (b[2] * b[2] + b[3] * b[3]); }
template <bool GELU = false>
__device__ __forceinline__ void head_ss_exchange(const f32x4 (&acc)[2][2][4][2], LAS float* xch, int wr, int wc, int fr, int fq, float (&tot)[2][4][2]) {
#pragma unroll
    for (int ai = 0; ai < 2; ++ai)
#pragma unroll
        for (int m = 0; m < 4; ++m)
#pragma unroll
            for (int bj = 0; bj < 2; ++bj) { f32x4 a0 = acc[ai][bj][m][0], a1 = acc[ai][bj][m][1];
                if (GELU) {
#pragma unroll
                    for (int j = 0; j < 4; ++j) { a0[j] = gelu_tanh(a0[j]); a1[j] = gelu_tanh(a1[j]); } }
                float ss = sumsq8(a0, a1); ss += __shfl_xor(ss, 16); ss += __shfl_xor(ss, 32);
                if (fq == 0) xch[((wr * 128 + (ai * 4 + m) * 16 + fr) * 2 + bj) * 4 + wc] = ss; }
    asm volatile("s_waitcnt lgkmcnt(0)" ::: "memory"); __builtin_amdgcn_s_barrier(); asm volatile("" ::: "memory");
#pragma unroll
    for (int ai = 0; ai < 2; ++ai)
#pragma unroll
        for (int m = 0; m < 4; ++m)
#pragma unroll
            for (int bj = 0; bj < 2; ++bj) { const f32x4 p = *(const LAS f32x4*)(xch + ((wr * 128 + (ai * 4 + m) * 16 + fr) * 2 + bj) * 4); tot[ai][m][bj] = (p[0] + p[1]) + (p[2] + p[3]); }
}
struct EpiInProj {
    LAS float* xch;
    __device__ __forceinline__ void operator()(const f32x4 (&acc)[2][2][4][2], const Unit& u, int wr, int wc, int fr, int fq) const {
        CArgs* ap = ARGP(); unsigned char* ws = ap->ws; unsigned char* ob = (unsigned char*)ap->out;
        bf16_t* QALL = (bf16_t*)(ob + R0_QB); bf16_t* Kb = (bf16_t*)(ob + R0_KB); bf16_t* GVb = (bf16_t*)(ob + R0_VN);
        bf16_t* Vb = (bf16_t*)(ws + WS_VB); bf16_t* Ub = (bf16_t*)(ws + WS_UB); bf16_t* GATES = (bf16_t*)(ws + WS_GATES);
        float* SSVP = (float*)(ws + WS_SMALL + SM_SSVP); const float* CS = (const float*)(ws + WS_SMALL + SM_CS);
        const float* q_norm = ap->q_norm; const float* k_norm = ap->k_norm; const float* mq_norm = ap->mq_norm;
        const int pn = u.pn; const int row0 = u.pm * BM + wr * 64 + fr, cl = wc * 32 + 8 * fq;
        if (pn < 5) {
            const bool isk = (pn == 4);
            float tot[2][4][2];
            head_ss_exchange(acc, xch, wr, wc, fr, fq, tot);
            const int hf = wc >> 1, f0 = 16 * (wc & 1) + 4 * fq, dh = 64 * hf + f0;
            const float* gn = isk ? k_norm : q_norm;
            const f32x4 g0 = *(const f32x4*)(gn + dh), g1 = *(const f32x4*)(gn + dh + 32);
#pragma unroll
            for (int ai = 0; ai < 2; ++ai) {
                f32x4 csv[4][2];
#pragma unroll
                for (int m = 0; m < 4; ++m) { const int t = row0 + ai * HALF + m * 16; const int pos = hf ? (t & 63) : (t >> 6);
                    const float* csp = CS + (size_t)(pos * 32 + f0) * 2; csv[m][0] = *(const f32x4*)csp; csv[m][1] = *(const f32x4*)(csp + 4); }
#pragma unroll
                for (int m = 0; m < 4; ++m) { const int t = row0 + ai * HALF + m * 16;
                    const f32x4 cs0 = csv[m][0], cs1 = csv[m][1];
                    const f32x4 cc = {cs0[0], cs0[2], cs1[0], cs1[2]}, sn = {cs0[1], cs0[3], cs1[1], cs1[3]};
#pragma unroll
                    for (int bj = 0; bj < 2; ++bj) { f32x4 v0 = acc[ai][bj][m][0], v1 = acc[ai][bj][m][1];
                        { const float r = __builtin_amdgcn_rsqf(tot[ai][m][bj] * (1.f / 128.f) + EPS); v0 *= r; v1 *= r; }
                        const f32x4 y0 = v0 * g0, y1 = v1 * g1;
                        const f32x4 o0 = y0 * cc - y1 * sn, o1 = y1 * cc + y0 * sn;
                        bf16_t* dst = isk ? Kb + (size_t)t * 256 + bj * 128 + dh : QALL + (size_t)t * 1536 + (pn * 2 + bj) * 128 + dh;
                        *(u32x2*)dst = pack4(o0); *(u32x2*)(dst + 32) = pack4(o1); } }
            }
            return;
        }
        if (pn >= 8 && pn < 12) {
            const bool isqm = pn >= 10;
            f32x4 g0 = {1.f, 1.f, 1.f, 1.f}, g1 = g0;
            if (isqm) { g0 = *(const f32x4*)(mq_norm + cl); g1 = *(const f32x4*)(mq_norm + cl + 4); }
            float tot[2][4][2];
            if (isqm) head_ss_exchange<false>(acc, xch, wr, wc, fr, fq, tot); else head_ss_exchange<true>(acc, xch, wr, wc, fr, fq, tot);
#pragma unroll
            for (int ai = 0; ai < 2; ++ai)
#pragma unroll
                for (int m = 0; m < 4; ++m) { const int t = row0 + ai * HALF + m * 16;
#pragma unroll
                    for (int bj = 0; bj < 2; ++bj) { f32x4 v0 = acc[ai][bj][m][0], v1 = acc[ai][bj][m][1];
                        if (isqm) { const float r = __builtin_amdgcn_rsqf(tot[ai][m][bj] * (1.f / 128.f) + EPS);
                            *(u32x4*)(QALL + (size_t)t * 1536 + 1024 + (pn - 10) * 256 + bj * HALF + cl) = pack8(v0 * r * g0, v1 * r * g1); }
                        else {
#pragma unroll
                            for (int j = 0; j < 4; ++j) { v0[j] = gelu_tanh(v0[j]); v1[j] = gelu_tanh(v1[j]); }
                            *(u32x4*)(GVb + (size_t)t * 512 + (pn - 8) * 256 + bj * HALF + cl) = pack8(v0, v1); } }
                    if (!isqm && wc == 0 && fq == 0) SSVP[(size_t)t * 2 + (pn - 8)] = tot[ai][m][0] + tot[ai][m][1]; }
            return;
        }
        int mode, ld, c0; bf16_t* base;
        if (pn == 5)      { base = Vb;    ld = 256;  c0 = 0; mode = 0; }
        else if (pn < 8)  { base = Ub;    ld = 512;  c0 = (pn - 6) * 256; mode = 1; }
        else              { base = GATES; ld = 6144; c0 = (pn - 12) * 256; mode = 2; }
#pragma unroll
        for (int ai = 0; ai < 2; ++ai)
#pragma unroll
            for (int m = 0; m < 4; ++m) { const size_t roff = (size_t)(row0 + ai * HALF + m * 16) * ld + c0 + cl;
#pragma unroll
                for (int bj = 0; bj < 2; ++bj) { f32x4 v0 = acc[ai][bj][m][0], v1 = acc[ai][bj][m][1];
                    if (mode == 1) {
#pragma unroll
                        for (int j = 0; j < 4; ++j) { v0[j] = gelu_tanh(v0[j]); v1[j] = gelu_tanh(v1[j]); } }
                    else if (mode == 2) {
#pragma unroll
                        for (int j = 0; j < 4; ++j) { v0[j] = sigmoidf_(v0[j]); v1[j] = sigmoidf_(v1[j]); } }
                    *(u32x4*)(base + roff + bj * HALF) = pack8(v0, v1); } }
    }
};
struct EpiMemKV {
    LAS float* xch;
    __device__ __forceinline__ void operator()(const f32x4 (&acc)[2][2][4][2], const Unit& u, int wr, int wc, int fr, int fq) const {
        CArgs* ap = ARGP(); unsigned char* ws = ap->ws; bf16_t* KMb = (bf16_t*)(ws + WS_SMALL + SM_KMB); bf16_t* VMb = (bf16_t*)(ws + WS_SMALL + SM_VMB); const float* mk_norm = ap->mk_norm;
        const int pn = u.pn; const int row0 = u.pm * BM + wr * 64 + fr, cl = wc * 32 + 8 * fq;
        float tot[2][4][2];
        if (pn < 2) head_ss_exchange(acc, xch, wr, wc, fr, fq, tot);
        const f32x4 g0 = *(const f32x4*)(mk_norm + cl), g1 = *(const f32x4*)(mk_norm + cl + 4);
#pragma unroll
        for (int ai = 0; ai < 2; ++ai)
#pragma unroll
            for (int m = 0; m < 4; ++m) { const size_t roff = (size_t)(pn & 1) * 65536 + (size_t)(row0 + ai * HALF + m * 16) * 256 + cl;
#pragma unroll
                for (int bj = 0; bj < 2; ++bj) { f32x4 v0 = acc[ai][bj][m][0], v1 = acc[ai][bj][m][1];
                    if (pn < 2) { const float r = __builtin_amdgcn_rsqf(tot[ai][m][bj] * (1.f / 128.f) + EPS); v0 = v0 * r * g0; v1 = v1 * r * g1; *(u32x4*)(KMb + roff + bj * HALF) = pack8(v0, v1); }
                    else { *(u32x4*)(VMb + roff + bj * HALF) = pack8(v0, v1); } } }
    }
};
__device__ __forceinline__ void unpack8(const u32x4 w, f32x4& lo, f32x4& hi) {
    lo[0] = __uint_as_float(w.x << 16); lo[1] = __uint_as_float(w.x & 0xffff0000u); lo[2] = __uint_as_float(w.y << 16); lo[3] = __uint_as_float(w.y & 0xffff0000u);
    hi[0] = __uint_as_float(w.z << 16); hi[1] = __uint_as_float(w.z & 0xffff0000u); hi[2] = __uint_as_float(w.w << 16); hi[3] = __uint_as_float(w.w & 0xffff0000u);
}
struct EpiBranch {
    __device__ __forceinline__ void operator()(f32x4 (&acc)[2][2][4][2], const Unit& u, int wr, int wc, int fr, int fq) const {
        unsigned char* ws = ARGP()->ws; const bf16_t* GATES = (const bf16_t*)(ws + WS_GATES); bf16_t* MERGED = (bf16_t*)(ws + WS_R0);
        const int br = u.tag; const int row0 = u.pm * BM + wr * 64 + fr, col0 = u.pn * BM + wc * 32 + 8 * fq;
        const bf16_t* gp = GATES + (size_t)row0 * 6144 + br * 2048 + col0;
#pragma unroll
        for (int ai = 0; ai < 2; ++ai) {
            u32x4 ga[4][2], gb[4][2];
#pragma unroll
            for (int m = 0; m < 4; ++m)
#pragma unroll
                for (int bj = 0; bj < 2; ++bj) { const bf16_t* p = gp + (size_t)(ai * HALF + m * 16) * 6144 + bj * HALF;
                    ga[m][bj] = *(const u32x4*)p; if (br < 2) gb[m][bj] = *(const u32x4*)(p + 2048); }
#pragma unroll
            for (int m = 0; m < 4; ++m)
#pragma unroll
                for (int bj = 0; bj < 2; ++bj) { f32x4 g0, g1; unpack8(ga[m][bj], g0, g1);
                    if (br < 2) { f32x4 h0, h1; unpack8(gb[m][bj], h0, h1);
#pragma unroll
                        for (int j = 0; j < 4; ++j) { g0[j] *= __builtin_amdgcn_rcpf(h0[j]); g1[j] *= __builtin_amdgcn_rcpf(h1[j]); }
                        acc[ai][bj][m][0] *= g0; acc[ai][bj][m][1] *= g1; }
                    else { *(u32x4*)(MERGED + (size_t)(row0 + ai * HALF + m * 16) * DM + col0 + bj * HALF) = pack8(acc[ai][bj][m][0] * g0, acc[ai][bj][m][1] * g1); } }
        }
    }
};
struct ResidInit {
    int which;
    __device__ __forceinline__ void operator()(f32x4 (&acc)[2][2][4][2], const Unit& u, int wr, int wc, int fr, int fq) const {
        CArgs* ap = ARGP(); const float* R = which ? (const float*)ap->out : ap->x;
        const int row0 = u.pm * BM + wr * 64 + fr, col0 = u.pn * BM + wc * 32 + 8 * fq;
#pragma unroll
        for (int ai = 0; ai < 2; ++ai)
#pragma unroll
            for (int m = 0; m < 4; ++m)
#pragma unroll
                for (int bj = 0; bj < 2; ++bj) { const float* p = R + (size_t)(row0 + ai * HALF + m * 16) * DM + col0 + bj * HALF; acc[ai][bj][m][0] = *(const f32x4*)p; acc[ai][bj][m][1] = *(const f32x4*)(p + 4); }
    }
};
struct EpiOut {
    LAS float* xch;
    __device__ __forceinline__ void operator()(const f32x4 (&acc)[2][2][4][2], const Unit& u, int wr, int wc, int fr, int fq) const {
        CArgs* ap = ARGP(); unsigned char* ws = ap->ws; const float* G = ap->norm_ffn; float* X1 = ap->out; bf16_t* A2 = (bf16_t*)(ws + WS_H); float* ROWSSP = (float*)(ws + WS_SMALL + SM_ROWSSP);
        float tot[2][4][2];
        head_ss_exchange(acc, xch, wr, wc, fr, fq, tot);
        const int row0 = u.pm * BM + wr * 64 + fr, col0 = u.pn * BM + wc * 32 + 8 * fq;
        f32x4 g[2][2];
#pragma unroll
        for (int bj = 0; bj < 2; ++bj) { g[bj][0] = *(const f32x4*)(G + col0 + bj * HALF); g[bj][1] = *(const f32x4*)(G + col0 + bj * HALF + 4); }
#pragma unroll
        for (int ai = 0; ai < 2; ++ai)
#pragma unroll
            for (int m = 0; m < 4; ++m) { const int row = row0 + ai * HALF + m * 16;
#pragma unroll
                for (int bj = 0; bj < 2; ++bj) { const size_t off = (size_t)row * DM + col0 + bj * HALF;
                    const f32x4 v0 = acc[ai][bj][m][0], v1 = acc[ai][bj][m][1];
                    *(f32x4*)(X1 + off) = v0; *(f32x4*)(X1 + off + 4) = v1;
                    *(u32x4*)(A2 + off) = pack8(v0 * g[bj][0], v1 * g[bj][1]); }
                if (wc == 0 && fq == 0) ROWSSP[(size_t)row * 8 + u.pn] = tot[ai][m][0] + tot[ai][m][1]; }
    }
};
struct EpiUp {
    int pm0; float rs0[2][4];
    __device__ static __forceinline__ void load_rs(const float* ROWSSP, int row0, float (&rs)[2][4]) {
        float rsv[2][4];
#pragma unroll
        for (int ai = 0; ai < 2; ++ai)
#pragma unroll
            for (int m = 0; m < 4; ++m) { const float* pp = ROWSSP + (size_t)(row0 + ai * HALF + m * 16) * 8; const f32x4 pa = *(const f32x4*)pp, pb = *(const f32x4*)(pp + 4);
                rsv[ai][m] = ((pa[0] + pa[1]) + (pa[2] + pa[3])) + ((pb[0] + pb[1]) + (pb[2] + pb[3])); }
#pragma unroll
        for (int ai = 0; ai < 2; ++ai)
#pragma unroll
            for (int m = 0; m < 4; ++m) rs[ai][m] = __builtin_amdgcn_rsqf(rsv[ai][m] * (1.0f / DM) + EPS);
    }
    __device__ __forceinline__ void operator()(const f32x4 (&acc)[2][2][4][2], const Unit& u, int wr, int wc, int fr, int fq) const {
        unsigned char* ws = ARGP()->ws; const float* ROWSSP = (const float*)(ws + WS_SMALL + SM_ROWSSP); bf16_t* U2 = (bf16_t*)(ws + WS_R0);
        const int row0 = u.pm * BM + wr * 64 + fr, col0 = u.pn * BM + wc * 32 + 8 * fq;
        float rs[2][4];
        if (u.pm == pm0) {
#pragma unroll
            for (int ai = 0; ai < 2; ++ai)
#pragma unroll
                for (int m = 0; m < 4; ++m) rs[ai][m] = rs0[ai][m];
        } else load_rs(ROWSSP, row0, rs);
#pragma unroll
        for (int ai = 0; ai < 2; ++ai)
#pragma unroll
            for (int m = 0; m < 4; ++m) { const int row = row0 + ai * HALF + m * 16;
#pragma unroll
                for (int bj = 0; bj < 2; ++bj) { f32x4 v0 = acc[ai][bj][m][0] * rs[ai][m], v1 = acc[ai][bj][m][1] * rs[ai][m];
#pragma unroll
                    for (int j = 0; j < 4; ++j) { const float a = fmaxf(v0[j], 0.f), b = fmaxf(v1[j], 0.f); v0[j] = a * a; v1[j] = b * b; }
                    *(u32x4*)(U2 + (size_t)row * DFF + col0 + bj * HALF) = pack8(v0, v1); } }
    }
};
struct EpiDown {
    __device__ __forceinline__ void operator()(const f32x4 (&acc)[2][2][4][2], const Unit& u, int wr, int wc, int fr, int fq) const {
        float* OUT = ARGP()->out;
        const int row0 = u.pm * BM + wr * 64 + fr, col0 = u.pn * BM + wc * 32 + 8 * fq;
#pragma unroll
        for (int ai = 0; ai < 2; ++ai)
#pragma unroll
            for (int m = 0; m < 4; ++m)
#pragma unroll
                for (int bj = 0; bj < 2; ++bj) { float* p = OUT + (size_t)(row0 + ai * HALF + m * 16) * DM + col0 + bj * HALF; *(f32x4*)p = acc[ai][bj][m][0]; *(f32x4*)(p + 4) = acc[ai][bj][m][1]; }
    }
};
}

namespace att {
constexpr int D = 128, NW = 8, QBLK = 32, KVBLK = 64;
constexpr float SCALE = 0.088388347648318440f;
constexpr float THR = 8.f;
constexpr size_t SHM_V = KVBLK * D * 2, SHM_K = KVBLK * D * 2, SHM_ATTN = 2 * SHM_V + 2 * SHM_K + NW * 64 * 4;
#define KSWZ(row, colB) ((row) * 256 + ((colB) ^ (((row) & 7) << 4)))
#define SBAR() __builtin_amdgcn_sched_barrier(0)
__device__ __forceinline__ int crow(int r, int hi) { return (r & 3) + 8 * (r >> 2) + 4 * hi; }
__device__ __forceinline__ void partialSM(f32x16& p0, f32x16& p1, float& m_reg, float& mn, float& alpha) {
  constexpr float C = SCALE * 1.4426950408889634f;
  float pmax = p0[0];
#pragma unroll
  for (int r = 1; r < 16; ++r) pmax = fmaxf(pmax, p0[r]);
#pragma unroll
  for (int r = 0; r < 16; ++r) pmax = fmaxf(pmax, p1[r]);
  { auto rr = __builtin_amdgcn_permlane32_swap(__float_as_uint(pmax), __float_as_uint(pmax), false, false);
    pmax = fmaxf(__uint_as_float(rr[0]), __uint_as_float(rr[1])); }
  if (__builtin_expect(__all(pmax - m_reg <= THR / SCALE), 1)) { mn = m_reg; alpha = 1.f; }
  else { mn = fmaxf(m_reg, pmax); alpha = __builtin_amdgcn_exp2f((m_reg - mn) * C); m_reg = mn; }
  float mnC = -mn * C;
#pragma unroll
  for (int r = 0; r < 16; ++r) p0[r] = fmaf(p0[r], C, mnC);
#pragma unroll
  for (int r = 0; r < 16; ++r) p1[r] = fmaf(p1[r], C, mnC);
#pragma unroll
  for (int r = 0; r < 16; ++r) p0[r] = __builtin_amdgcn_exp2f(p0[r]);
}
__device__ __forceinline__ void finishSM(f32x16& p0, f32x16& p1, float alpha, float& l_reg, bf16x8& pa0, bf16x8& pa1, bf16x8& pa2, bf16x8& pa3) {
#pragma unroll
  for (int r = 0; r < 16; ++r) p1[r] = __builtin_amdgcn_exp2f(p1[r]);
  float ps = 0;
#pragma unroll
  for (int r = 0; r < 16; ++r) ps += p0[r];
#pragma unroll
  for (int r = 0; r < 16; ++r) ps += p1[r];
  { auto rr = __builtin_amdgcn_permlane32_swap(__float_as_uint(ps), __float_as_uint(ps), false, false);
    ps = __uint_as_float(rr[0]) + __uint_as_float(rr[1]); }
  l_reg = l_reg * alpha + ps;
#define PK4(P, BASE, OUT) do { unsigned a0 = cvt_pk_bf16(P[BASE + 0], P[BASE + 1]), a1 = cvt_pk_bf16(P[BASE + 2], P[BASE + 3]);   \
    unsigned b0 = cvt_pk_bf16(P[BASE + 4], P[BASE + 5]), b1 = cvt_pk_bf16(P[BASE + 6], P[BASE + 7]);                              \
    auto r0 = __builtin_amdgcn_permlane32_swap(a0, b0, false, false); auto r1 = __builtin_amdgcn_permlane32_swap(a1, b1, false, false); \
    u32x4 w = {r0[0], r1[0], r0[1], r1[1]}; OUT = *reinterpret_cast<bf16x8*>(&w); } while (0)
  PK4(p0, 0, pa0); PK4(p0, 8, pa1); PK4(p1, 0, pa2); PK4(p1, 8, pa3);
#undef PK4
}
__device__ __forceinline__ void qkt(f32x16& p0, f32x16& p1, const bf16_t* Ks, const bf16x8* qr, int r32, int hi) {
  p0 = f32x16{}; p1 = f32x16{};
#pragma unroll
  for (int d0 = 0; d0 < 8; ++d0) { int cb = (d0 * 16 + hi * 8) * 2;
    bf16x8 b0 = *reinterpret_cast<const bf16x8*>((const char*)Ks + KSWZ(r32, cb));
    bf16x8 b1 = *reinterpret_cast<const bf16x8*>((const char*)Ks + KSWZ(32 + r32, cb));
    p0 = __builtin_amdgcn_mfma_f32_32x32x16_bf16(b0, qr[d0], p0, 0, 0, 0);
    p1 = __builtin_amdgcn_mfma_f32_32x32x16_bf16(b1, qr[d0], p1, 0, 0, 0); }
}
__device__ __forceinline__ int v_st(int k, int c) { const int kk = (k & ~0xC) | ((k & 4) << 1) | ((k & 8) >> 1); return ((kk >> 3) * 4 + (c >> 5)) * 512 + ((kk & 7) * 32 + (c & 31)) * 2; }
__device__ __forceinline__ int v_rd_base(int lane) { return ((lane & 3) << 3) | (((lane >> 2) & 3) << 6) | (((lane >> 4) & 1) << 5) | (((lane >> 5) & 1) << 8); }
constexpr int v_rd_off(int d0, int ks, int half) { return d0 * 512 + ks * 4096 + half * 2048; }
template <int OFF> __device__ __forceinline__ s16x4 tr_read(int vb) {
  s16x4 r; asm volatile("ds_read_b64_tr_b16 %0, %1 offset:%2" : "=&v"(r) : "v"(vb), "i"(OFF) : "memory"); return r;
}
template <int D0> __device__ __forceinline__ void pv_one(f32x16& od, int vb, bf16x8 pa0, bf16x8 pa1, bf16x8 pa2, bf16x8 pa3) {
  const s16x4 l0 = tr_read<v_rd_off(D0, 0, 0)>(vb), h0 = tr_read<v_rd_off(D0, 0, 1)>(vb), l1 = tr_read<v_rd_off(D0, 1, 0)>(vb), h1 = tr_read<v_rd_off(D0, 1, 1)>(vb);
  const s16x4 l2 = tr_read<v_rd_off(D0, 2, 0)>(vb), h2 = tr_read<v_rd_off(D0, 2, 1)>(vb), l3 = tr_read<v_rd_off(D0, 3, 0)>(vb), h3 = tr_read<v_rd_off(D0, 3, 1)>(vb);
  asm volatile("s_waitcnt lgkmcnt(0)" ::: "memory"); SBAR();
#define PK(L, H) (bf16x8){L[0], L[1], L[2], L[3], H[0], H[1], H[2], H[3]}
  od = __builtin_amdgcn_mfma_f32_32x32x16_bf16(pa0, PK(l0, h0), od, 0, 0, 0);
  od = __builtin_amdgcn_mfma_f32_32x32x16_bf16(pa1, PK(l1, h1), od, 0, 0, 0);
  od = __builtin_amdgcn_mfma_f32_32x32x16_bf16(pa2, PK(l2, h2), od, 0, 0, 0);
  od = __builtin_amdgcn_mfma_f32_32x32x16_bf16(pa3, PK(l3, h3), od, 0, 0, 0);
#undef PK
}
#define PV_BLOCK_READS(D0) \
  const s16x4 l0_##D0 = tr_read<v_rd_off(D0, 0, 0)>(vb), h0_##D0 = tr_read<v_rd_off(D0, 0, 1)>(vb), l1_##D0 = tr_read<v_rd_off(D0, 1, 0)>(vb), h1_##D0 = tr_read<v_rd_off(D0, 1, 1)>(vb); \
  const s16x4 l2_##D0 = tr_read<v_rd_off(D0, 2, 0)>(vb), h2_##D0 = tr_read<v_rd_off(D0, 2, 1)>(vb), l3_##D0 = tr_read<v_rd_off(D0, 3, 0)>(vb), h3_##D0 = tr_read<v_rd_off(D0, 3, 1)>(vb);
#define PKV(L, H) (bf16x8){L[0], L[1], L[2], L[3], H[0], H[1], H[2], H[3]}
#define PV_BLOCK_MMA(D0) \
  asm volatile("s_waitcnt lgkmcnt(0)" ::: "memory"); SBAR(); \
  o[D0] = __builtin_amdgcn_mfma_f32_32x32x16_bf16(pa0, PKV(l0_##D0, h0_##D0), o[D0], 0, 0, 0); \
  o[D0] = __builtin_amdgcn_mfma_f32_32x32x16_bf16(pa1, PKV(l1_##D0, h1_##D0), o[D0], 0, 0, 0); \
  o[D0] = __builtin_amdgcn_mfma_f32_32x32x16_bf16(pa2, PKV(l2_##D0, h2_##D0), o[D0], 0, 0, 0); \
  o[D0] = __builtin_amdgcn_mfma_f32_32x32x16_bf16(pa3, PKV(l3_##D0, h3_##D0), o[D0], 0, 0, 0);
#define SGB4(NV) do { __builtin_amdgcn_sched_group_barrier(0x008, 1, 0); __builtin_amdgcn_sched_group_barrier(0x002, NV, 0); __builtin_amdgcn_sched_group_barrier(0x008, 1, 0); __builtin_amdgcn_sched_group_barrier(0x002, NV, 0); \
    __builtin_amdgcn_sched_group_barrier(0x008, 1, 0); __builtin_amdgcn_sched_group_barrier(0x002, NV, 0); __builtin_amdgcn_sched_group_barrier(0x008, 1, 0); __builtin_amdgcn_sched_group_barrier(0x002, NV, 0); } while (0)
__device__ __forceinline__ void pv_sm(f32x16* o, int vb, bf16x8 pa0, bf16x8 pa1, bf16x8 pa2, bf16x8 pa3, f32x16& p0, f32x16& p1, float& m_reg, float& mn, float& alpha) {
  constexpr float C = SCALE * 1.4426950408889634f;
  { PV_BLOCK_READS(0)
    PV_BLOCK_MMA(0)
    float pmax = p0[0];
#pragma unroll
    for (int r = 1; r < 16; ++r) pmax = fmaxf(pmax, p0[r]);
    mn = pmax;
    SGB4(2); }
  { PV_BLOCK_READS(1)
    PV_BLOCK_MMA(1)
    float pmax = mn;
#pragma unroll
    for (int r = 0; r < 16; ++r) pmax = fmaxf(pmax, p1[r]);
    mn = pmax;
    SGB4(2); }
  { auto rr = __builtin_amdgcn_permlane32_swap(__float_as_uint(mn), __float_as_uint(mn), false, false);
    const float pmax = fmaxf(__uint_as_float(rr[0]), __uint_as_float(rr[1]));
    const bool keep = __all(pmax - m_reg <= THR / SCALE);
    mn = keep ? m_reg : fmaxf(m_reg, pmax); alpha = __builtin_amdgcn_exp2f((m_reg - mn) * C); m_reg = mn; }
  { PV_BLOCK_READS(2)
    PV_BLOCK_MMA(2)
    const float mnC = -mn * C;
#pragma unroll
    for (int r = 0; r < 16; ++r) p0[r] = fmaf(p0[r], C, mnC);
#pragma unroll
    for (int r = 0; r < 16; ++r) p1[r] = fmaf(p1[r], C, mnC);
    SGB4(8); }
  { PV_BLOCK_READS(3)
    PV_BLOCK_MMA(3)
#pragma unroll
    for (int r = 0; r < 16; ++r) p0[r] = __builtin_amdgcn_exp2f(p0[r]);
    SGB4(4); }
}
#undef SGB4
#undef PV_BLOCK_READS
#undef PV_BLOCK_MMA
#undef PKV
__device__ __forceinline__ void pv_d0(f32x16* o, int vb, bf16x8 pa0, bf16x8 pa1, bf16x8 pa2, bf16x8 pa3) {
  pv_one<0>(o[0], vb, pa0, pa1, pa2, pa3); pv_one<1>(o[1], vb, pa0, pa1, pa2, pa3); pv_one<2>(o[2], vb, pa0, pa1, pa2, pa3); pv_one<3>(o[3], vb, pa0, pa1, pa2, pa3);
}
template <int LDQ, int LDK, int LDO>
__device__ __forceinline__ void attn_dense_body(const bf16_t* __restrict__ Qb, const bf16_t* __restrict__ Kh, const bf16_t* __restrict__ Vh,
                                                bf16_t* __restrict__ Ob, int seq, char* lds, const float* __restrict__ ssq, const int tid) {
  const int wid = tid >> 6, lane = tid & 63, r32 = lane & 31, hi = lane >> 5;
  bf16_t* V_lds = (bf16_t*)lds; bf16_t* K_lds = (bf16_t*)(lds + 2 * SHM_V);
  float* ws = (float*)(lds + 2 * SHM_V + 2 * SHM_K) + wid * 64; float* li_l = ws; float* al_l = ws + 32;
  float m_reg = -1e30f, l_reg = 0; f32x16 o[4] = {}; bf16x8 qr[8];
  const bf16_t* Qw = Qb + (long)(wid * QBLK + r32) * LDQ + hi * 8;
  const float rq = __builtin_amdgcn_rsqf(ssq[(wid * QBLK + r32) * 16] * (1.f / 128.f) + EPS);
#pragma unroll
  for (int d0 = 0; d0 < 8; ++d0) { const u32x4 w = *reinterpret_cast<const u32x4*>(Qw + d0 * 16); f32x4 lo, hi2; pg8::unpack8(w, lo, hi2);
    const u32x4 o = pg8::pack8(lo * rq, hi2 * rq); qr[d0] = *reinterpret_cast<const bf16x8*>(&o); }
  const int sr = tid >> 4, sc = (tid & 15) * 8, vst0 = v_st(sr, sc), vst1 = v_st(32 + sr, sc);
  const int vb0 = (int)(uintptr_t)V_lds + v_rd_base(lane);
  struct { bf16x8 vs0, vs1, ks0, ks1; } sr_[2];
#define SLOAD(i, k0) do { sr_[i].vs0 = *reinterpret_cast<const bf16x8*>(&Vh[(long)((k0) + sr) * LDK + sc]); sr_[i].vs1 = *reinterpret_cast<const bf16x8*>(&Vh[(long)((k0) + 32 + sr) * LDK + sc]); \
    sr_[i].ks0 = *reinterpret_cast<const bf16x8*>(&Kh[(long)((k0) + sr) * LDK + sc]); sr_[i].ks1 = *reinterpret_cast<const bf16x8*>(&Kh[(long)((k0) + 32 + sr) * LDK + sc]); } while (0)
#define SWRITE(b, i) do { *(bf16x8*)((char*)V_lds + (b) * SHM_V + vst0) = sr_[i].vs0;          \
    *(bf16x8*)((char*)V_lds + (b) * SHM_V + vst1) = sr_[i].vs1; int kc = sc * 2;               \
    *(bf16x8*)((char*)K_lds + (b) * SHM_K + KSWZ(sr, kc)) = sr_[i].ks0;                       \
    *(bf16x8*)((char*)K_lds + (b) * SHM_K + KSWZ(32 + sr, kc)) = sr_[i].ks1; } while (0)
#define SWAIT() asm volatile("s_waitcnt vmcnt(4)" ::: "memory")
#define RESC(a) do { if (__any((a) < 1.f)) { if (hi == 0) al_l[r32] = (a); asm volatile("s_waitcnt lgkmcnt(0)" ::: "memory"); \
    _Pragma("unroll") for (int d = 0; d < 4; ++d) _Pragma("unroll") for (int r = 0; r < 16; ++r) o[d][r] *= al_l[crow(r, hi)]; } } while (0)
  f32x16 pA0, pA1, pB0, pB1; float mnA, mnB, alA, alB; bf16x8 pa0, pa1, pa2, pa3; const int NT = seq / KVBLK;
  constexpr int SE = 0, SO = 1;
  SLOAD(SE, 0); asm volatile("s_waitcnt vmcnt(0)" ::: "memory"); SWRITE(0, SE); __syncthreads();
  qkt(pA0, pA1, K_lds, qr, r32, hi); partialSM(pA0, pA1, m_reg, mnA, alA);
  SLOAD(SO, KVBLK); if (2 < NT) SLOAD(SE, 2 * KVBLK);
  SWAIT(); SWRITE(1, SO); __syncthreads();
  for (int j = 1; j + 1 < NT; j += 2) {
    SBAR(); qkt(pB0, pB1, (bf16_t*)((char*)K_lds + SHM_K), qr, r32, hi);
    finishSM(pA0, pA1, alA, l_reg, pa0, pa1, pa2, pa3); SBAR();
    SLOAD(SO, (j + 2) * KVBLK); SBAR();
    pv_sm(o, vb0, pa0, pa1, pa2, pa3, pB0, pB1, m_reg, mnB, alB);
    __syncthreads(); SWAIT(); SWRITE(0, SE);
    RESC(alB); __syncthreads();
    SBAR(); qkt(pA0, pA1, K_lds, qr, r32, hi);
    finishSM(pB0, pB1, alB, l_reg, pa0, pa1, pa2, pa3); SBAR();
    if (j + 3 < NT) SLOAD(SE, (j + 3) * KVBLK); SBAR();
    pv_sm(o, vb0 + (int)SHM_V, pa0, pa1, pa2, pa3, pA0, pA1, m_reg, mnA, alA);
    __syncthreads(); SWAIT(); SWRITE(1, SO);
    RESC(alA); __syncthreads();
  }
  SBAR(); qkt(pB0, pB1, (bf16_t*)((char*)K_lds + SHM_K), qr, r32, hi);
  finishSM(pA0, pA1, alA, l_reg, pa0, pa1, pa2, pa3); SBAR();
  pv_sm(o, vb0, pa0, pa1, pa2, pa3, pB0, pB1, m_reg, mnB, alB);
  __syncthreads(); RESC(alB);
  finishSM(pB0, pB1, alB, l_reg, pa0, pa1, pa2, pa3); SBAR();
  pv_d0(o, vb0 + (int)SHM_V, pa0, pa1, pa2, pa3);
  if (hi == 0) li_l[r32] = l_reg; asm volatile("s_waitcnt lgkmcnt(0)" ::: "memory");
  float rli[16];
#pragma unroll
  for (int r = 0; r < 16; ++r) rli[r] = __builtin_amdgcn_rcpf(li_l[crow(r, hi)]);
  bf16_t* Ow = Ob + (long)(wid * QBLK) * LDO;
#pragma unroll
  for (int r = 0; r < 16; ++r) { int orow = crow(r, hi);
#pragma unroll
    for (int d0 = 0; d0 < 4; ++d0) Ow[(long)orow * LDO + d0 * 32 + r32] = (bf16_t)(cvt_pk_bf16(o[d0][r] * rli[r], 0.f) & 0xffffu); }
  __syncthreads();
#undef SLOAD
#undef SWRITE
#undef SWAIT
#undef RESC
}
}

__device__ __forceinline__ void transpose_item(const float* __restrict__ W, int N, bf16_t* __restrict__ WT, int ldt, int koff, LAS float* scr, int kb, int nb, int lane, int nperm) {
    const int k0 = 64 * kb, n0 = 64 * nb, lr = lane >> 4, lc = (lane & 15) * 4;
    const float* p = W + (size_t)(k0 + lr) * N + n0 + lc; const size_t step = (size_t)4 * N;
    f32x4 v[16];
#pragma unroll
    for (int i = 0; i < 16; ++i) { v[i] = *(const f32x4*)p; p += step; }
#pragma unroll
    for (int i = 0; i < 16; ++i) { LAS float* d = scr + (4 * i + lr) * 65 + lc; d[0] = v[i][0]; d[1] = v[i][1]; d[2] = v[i][2]; d[3] = v[i][3]; }
    asm volatile("s_waitcnt lgkmcnt(0)" ::: "memory");
    const int c = lane & 7;
#pragma unroll
    for (int j = 0; j < 8; ++j) { const int n = (lane >> 3) + 8 * j; const LAS float* s = scr + (8 * c) * 65 + n;
        u32x4 o; o.x = cvt_pk_bf16(s[0 * 65], s[1 * 65]); o.y = cvt_pk_bf16(s[2 * 65], s[3 * 65]); o.z = cvt_pk_bf16(s[4 * 65], s[5 * 65]); o.w = cvt_pk_bf16(s[6 * 65], s[7 * 65]);
        const int dn = (n0 < nperm) ? n0 + 8 * ((n & 31) >> 2) + 4 * (n >> 5) + (n & 3) : n0 + n;
        *(u32x4*)(WT + (size_t)dn * ldt + koff + k0 + 8 * c) = o; }
    asm volatile("s_waitcnt lgkmcnt(0)" ::: "memory");
}
__device__ __forceinline__ void rms_row_to_bf16(const float* __restrict__ xrow, const float* __restrict__ g, bf16_t* __restrict__ orow, int lane) {
    const f32x4* xr = (const f32x4*)xrow + lane; const f32x4* gr = (const f32x4*)g + lane;
    f32x4 v[8]; float s = 0.f;
#pragma unroll
    for (int j = 0; j < 8; ++j) { v[j] = xr[64 * j]; s += (v[j][0] * v[j][0] + v[j][1] * v[j][1]) + (v[j][2] * v[j][2] + v[j][3] * v[j][3]); }
    const float r = __builtin_amdgcn_rsqf(wave_sum(s) * (1.f / DM) + EPS);
    u32x2* o8 = (u32x2*)orow + lane;
#pragma unroll
    for (int j = 0; j < 8; ++j) { const f32x4 gg = gr[64 * j]; u32x2 w; w.x = cvt_pk_bf16(v[j][0] * r * gg[0], v[j][1] * r * gg[1]); w.y = cvt_pk_bf16(v[j][2] * r * gg[2], v[j][3] * r * gg[3]); o8[64 * j] = w; }
}
__device__ __forceinline__ void sincos_pos(float af, float& s, float& c) {
    const double a = (double)af;
    const double n = __builtin_rint(a * 0.63661977236758134308);
    const double r = __builtin_fma(-n, 1.57079632679489661923, a) - n * 6.12323399573676603587e-17;
    const double r2 = r * r;
    double ps = -2.5052108385441718775e-08; ps = ps * r2 + 2.7557319223985890653e-06; ps = ps * r2 - 1.9841269841269841270e-04; ps = ps * r2 + 8.3333333333333333333e-03; ps = ps * r2 - 1.6666666666666666667e-01;
    const double sr = r + r * r2 * ps;
    double pc = 2.0876756987868098979e-09; pc = pc * r2 - 2.7557319223985890653e-07; pc = pc * r2 + 2.4801587301587301587e-05; pc = pc * r2 - 1.3888888888888888889e-03; pc = pc * r2 + 4.1666666666666666667e-02; pc = pc * r2 - 0.5;
    const double cr = 1.0 + r2 * pc;
    const int q = ((int)n) & 3;
    const double ss = (q & 1) ? cr : sr, cc = (q & 1) ? sr : cr;
    s = (float)((q & 2) ? -ss : ss); c = (float)(((q + 1) & 2) ? -cc : cc);
}

constexpr int I_IN = (DM / 64) * (INW / 64), I_MKV = (DM / 64) * (1024 / 64), I_AO = (1024 / 64) * (DM / 64), I_GO = (512 / 64) * (DM / 64), I_MO = I_GO,
              I_OUT = (DM / 64) * (DM / 64), I_UP = (DM / 64) * (DFF / 64), I_DN = (DFF / 64) * (DM / 64);
constexpr int IT_EARLY = I_IN + I_MKV, NITEMS = IT_EARLY + I_AO + I_GO + I_MO + I_OUT + I_UP + I_DN, IT_P0 = IT_EARLY;

#define XB_TMO      128
#define XB_XCNT(j)  (256  + 64 * (j))
#define XB_XSUB(j)  (1280 + 64 * (j))
#define XB_XGEN(j)  (2304 + 64 * (j))
#define XB_TOP      3328
#define XB_TOPGEN   3392
#define XCD_BAR_WORDS 3456
#define XB_SPIN_CAP (1u << 18)
__device__ __forceinline__ unsigned xb_ld(unsigned* p)              { return __hip_atomic_load(p, __ATOMIC_RELAXED, __HIP_MEMORY_SCOPE_AGENT); }
__device__ __forceinline__ unsigned xb_add(unsigned* p, unsigned v) { return __hip_atomic_fetch_add(p, v, __ATOMIC_RELAXED, __HIP_MEMORY_SCOPE_AGENT); }
__device__ __forceinline__ unsigned xb_xcc_id() { return (unsigned)__builtin_amdgcn_s_getreg((3 << 11) | 20) & 0xFu; }
#define XB_SPIN(cond, bar) do { unsigned _sp = 0; while (cond) { __builtin_amdgcn_s_sleep(1); \
    if ((++_sp & 255u) == 0u) { if (xb_ld(&(bar)[XB_TMO])) break; if (_sp > XB_SPIN_CAP) { atomicAdd(&(bar)[XB_TMO], 1u); break; } } } } while (0)
struct XcdBarrier { unsigned* bar; unsigned x; volatile LAS unsigned* st; };
__device__ __forceinline__ XcdBarrier xcd_barrier_post(unsigned* bar, volatile LAS unsigned* st) {
    XcdBarrier b; b.bar = bar; b.x = xb_xcc_id(); b.st = st;
    if (threadIdx.x == 0) (void)xb_add(&bar[XB_XCNT(b.x)], 1u);
    return b;
}
__device__ __forceinline__ void xcd_barrier_complete(unsigned* bar, unsigned x, unsigned& nloc, unsigned& nx) {
    const unsigned G = gridDim.x * gridDim.y * gridDim.z;
    unsigned sum, cnt, mine, sp = 0u;
    for (;;) {
        sum = 0u; cnt = 0u; mine = 0u;
#pragma unroll
        for (unsigned j = 0; j < 16; ++j) { const unsigned c = xb_ld(&bar[XB_XCNT(j)]); sum += c; cnt += (c > 0u) ? 1u : 0u; mine = (j == x) ? c : mine; }
        if (sum == G) break;
        __builtin_amdgcn_s_sleep(1);
        if ((++sp & 255u) == 0u) { if (xb_ld(&bar[XB_TMO])) break; if (sp > XB_SPIN_CAP) { atomicAdd(&bar[XB_TMO], 1u); break; } }
    }
    nloc = mine > 0u ? mine : 1u; nx = cnt > 0u ? cnt : 1u;
}
__device__ __forceinline__ void xcd_barrier(const XcdBarrier& b, const int wave) {
    asm volatile("s_waitcnt vmcnt(0)" ::: "memory");
    __syncthreads();
    if (wave == 0 && __builtin_amdgcn_mbcnt_lo(~0u, 0u) == 0u) {
        unsigned* bar = b.bar;
        __builtin_amdgcn_s_waitcnt(0);
        unsigned nloc = b.st[0], nx = b.st[1];
        if (nloc == 0u) { xcd_barrier_complete(bar, b.x, nloc, nx); b.st[0] = nloc; b.st[1] = nx; }
        const unsigned old = xb_add(&bar[XB_XSUB(b.x)], 1u);
        const unsigned gen = old / nloc;
        if (old + 1u == (gen + 1u) * nloc) {
            __builtin_amdgcn_fence(__ATOMIC_RELEASE, "agent");
            asm volatile("s_waitcnt vmcnt(0)" ::: "memory");
            const unsigned og = xb_add(&bar[XB_TOP], 1u);
            const unsigned tg = og / nx;
            if (og + 1u == (tg + 1u) * nx) xb_add(&bar[XB_TOPGEN], 1u);
            else XB_SPIN(xb_ld(&bar[XB_TOPGEN]) == tg, bar);
            __builtin_amdgcn_fence(__ATOMIC_ACQUIRE, "agent");
            xb_add(&bar[XB_XGEN(b.x)], 1u);
            asm volatile("s_waitcnt vmcnt(0)" ::: "memory");
        } else {
            XB_SPIN(xb_ld(&bar[XB_XGEN(b.x)]) == gen, bar);
            __builtin_amdgcn_fence(__ATOMIC_ACQUIRE, "agent");
            asm volatile("s_waitcnt vmcnt(0)" ::: "memory");
        }
    }
    __syncthreads();
}

__global__ void __launch_bounds__(512, 1) fwd_megakernel(Args a_unused) {
    extern __shared__ __attribute__((aligned(16))) unsigned char lds_raw[];
    LAS unsigned char* lds = (LAS unsigned char*)lds_raw;
    const int tid0 = threadIdx.x, wave = __builtin_amdgcn_readfirstlane(tid0 >> 6);
    const int G = gridDim.x, bx = blockIdx.x;
    const int gw = bx * 8 + wave, NGW = G * 8;
#define a (*ap)
#define PHASE_ENTER() int tid_; asm volatile("v_mbcnt_lo_u32_b32 %0, -1, 0\n\tv_mbcnt_hi_u32_b32 %0, -1, %0\n\tv_lshl_add_u32 %0, %1, 6, %0" : "=&v"(tid_) : "s"(wave));   \
    const int tid = tid_ & 511, lane = tid & 63; (void)lane; \
    CArgs* ap = ARGP(); unsigned char* ws = a.ws; \
    bf16_t* WdownT = (bf16_t*)(ws + WS_WDOWN); bf16_t* WupT = (bf16_t*)(ws + WS_WUP); bf16_t* WoutT = (bf16_t*)(ws + WS_WOUT); bf16_t* WcatT = (bf16_t*)(ws + WS_WCAT); \
    bf16_t* Hb = (bf16_t*)(ws + WS_H); bf16_t* XCAT = Hb; bf16_t* A2 = Hb; \
    float* SSVP = (float*)(ws + WS_SMALL + SM_SSVP); float* SSQ = (float*)(ws + WS_SMALL + SM_SSQ); float* CS = (float*)(ws + WS_SMALL + SM_CS); bf16_t* MEMN = (bf16_t*)(ws + WS_SMALL + SM_MEMN); \
    bf16_t* KMb = (bf16_t*)(ws + WS_SMALL + SM_KMB); bf16_t* VMb = (bf16_t*)(ws + WS_SMALL + SM_VMB); \
    bf16_t* WinT = (bf16_t*)(ws + WS_R0); bf16_t* Qb = (bf16_t*)((unsigned char*)a.out + R0_QB); bf16_t* Kb = (bf16_t*)((unsigned char*)a.out + R0_KB); bf16_t* GVb = (bf16_t*)((unsigned char*)a.out + R0_VN); \
    bf16_t* MERGED = (bf16_t*)(ws + WS_R0); bf16_t* U2 = (bf16_t*)(ws + WS_R0); \
    bf16_t* WmkvT = (bf16_t*)(ws + WS_WMKV); bf16_t* GATES = (bf16_t*)(ws + WS_GATES); \
    bf16_t* Vb = (bf16_t*)(ws + WS_VB); bf16_t* Ub = (bf16_t*)(ws + WS_UB); \
    LAS float* xch = (LAS float*)(lds + LDS_XCH_OFF);
    const int lo = ((CArgs*)__builtin_amdgcn_kernarg_segment_ptr())->ph_lo, hi = ((CArgs*)__builtin_amdgcn_kernarg_segment_ptr())->ph_hi;
#ifndef PHASE_MASK
#define PHASE_MASK 0xff
#endif
#define IN(k) (((PHASE_MASK >> (k)) & 1) && lo <= (k) && (k) < hi)
    volatile LAS unsigned* xb_st = (volatile LAS unsigned*)(lds + LDS_ST_OFF);
    if (tid0 == 0) { xb_st[0] = 0u; xb_st[1] = 0u; }
    __syncthreads();
    const XcdBarrier xbar = xcd_barrier_post((unsigned*)(((CArgs*)__builtin_amdgcn_kernarg_segment_ptr())->ws + WS_SMALL + SM_BAR), xb_st);
#define SYNC(k) do { if (IN(k)) xcd_barrier(xbar, wave); } while (0)

    if (IN(0)) { PHASE_ENTER();
        for (int i = bx * 512 + tid; i < S * 4; i += G * 512) ((f32x4*)SSQ)[i] = (f32x4){127.999872f, 127.999872f, 127.999872f, 127.999872f};
        for (int i = bx * 512 + tid; i < 128 * 32; i += G * 512) {
            const int pos = i >> 5, f = i & 31; float sn, cs; sincos_pos((float)pos * __builtin_amdgcn_exp2f((float)f * (-13.287712379549449f / 32.0f)), sn, cs);
            CS[2 * i] = cs; CS[2 * i + 1] = sn; }
        LAS float* scr = (LAS float*)(lds + wave * 16640);
#define TRANSPOSE_ITEMS(IT0, IT1, W0, NW_) \
        for (int it = (IT0) + (W0); it < (IT1); it += (NW_)) { \
            int r = it; const float* W; bf16_t* WT; int N, ldt, koff, nperm = 0; \
            if (r < I_IN) { W = a.w_in; N = INW; WT = WinT; ldt = DM; koff = 0; nperm = 1280; } \
            else if ((r -= I_IN) < I_MKV) { W = a.w_mem_kv; N = 1024; WT = WmkvT; ldt = DM; koff = 0; } \
            else if ((r -= I_MKV) < I_AO) { W = a.w_attn_o; N = DM; WT = WcatT; ldt = DM; koff = 0; } \
            else if ((r -= I_AO) < I_GO) { W = a.w_gmlp_o; N = DM; WT = WcatT; ldt = DM; koff = 1024; } \
            else if ((r -= I_GO) < I_MO) { W = a.w_mem_o; N = DM; WT = WcatT; ldt = DM; koff = 1536; } \
            else if ((r -= I_MO) < I_OUT) { W = a.w_out; N = DM; WT = WoutT; ldt = DM; koff = 0; } \
            else if ((r -= I_OUT) < I_UP) { W = a.w_ffn_up; N = DFF; WT = WupT; ldt = DM; koff = 0; } \
            else { r -= I_UP; W = a.w_ffn_down; N = DM; WT = WdownT; ldt = DFF; koff = 0; } \
              \
            const int nbk = N >> 6, g8 = 8 * nbk, kb8 = r / g8, rem = r - kb8 * g8; \
            transpose_item(W, N, WT, ldt, koff, scr, kb8 * 8 + (rem & 7), rem >> 3, lane, nperm); \
        }
        TRANSPOSE_ITEMS(0, IT_P0, gw, NGW)
        for (int m = gw; m < S + MEMT; m += NGW) {
            if (m < S) rms_row_to_bf16(a.x + (size_t)m * DM, a.norm_mix, Hb + (size_t)m * DM, lane);
            else rms_row_to_bf16(a.mem + (size_t)(m - S) * DM, a.mem_norm, MEMN + (size_t)(m - S) * DM, lane);
        }
        __syncthreads();
    }
    SYNC(0);

    if (IN(1)) { PHASE_ENTER();
        { pg8::Gemm g{Hb, WinT, DM}; pg8::InProjOrder So; So.init(S, INW, DM, G, bx);
          pg8::EpiInProj E{xch};
          pg8::gemm_phase(lds, g, So, E, tid); }
        { pg8::Gemm g{MEMN, WmkvT, DM}; pg8::StaticOrder So; So.init(MEMT, 1024, DM, G, (bx + G / 2) % G);
          pg8::EpiMemKV E{xch};
          pg8::gemm_phase(lds, g, So, E, tid); }
        if (bx >= G / 2 + 4) {
            LAS float* scr = (LAS float*)(lds + wave * 16640);
            TRANSPOSE_ITEMS(IT_P0, NITEMS, (bx - G / 2 - 4) * 8 + wave, (G - G / 2 - 4) * 8)
            __syncthreads();
        }
    }
    SYNC(1);


    if (IN(3)) { PHASE_ENTER();
#ifndef P3_MASK
#define P3_MASK 7
#endif
        if (P3_MASK & 1) for (int w = bx; w < 384; w += G) {
            const bool self = w < 256; const int h = self ? (w & 7) : (w & 3), qb = self ? (w >> 3) : ((w - 256) >> 2);
            const bf16_t* Qp = Qb + (size_t)qb * 256 * 1536 + (self ? h * 128 : 1024 + h * 128);
            const bf16_t* Kp = self ? Kb + (h >> 2) * 128 : KMb + (size_t)(h >> 1) * 65536 + (h & 1) * 128;
            const bf16_t* Vp = self ? Vb + (h >> 2) * 128 : VMb + (size_t)(h >> 1) * 65536 + (h & 1) * 128;
            bf16_t* Op = XCAT + (size_t)qb * 256 * 2048 + (self ? h * 128 : 1536 + h * 128);
            att::attn_dense_body<1536, 256, 2048>(Qp, Kp, Vp, Op, self ? S : MEMT, (char*)lds_raw, SSQ + (size_t)qb * 256 * 16 + (self ? h : 8 + h), tid);
        }
        if ((P3_MASK & 4) && bx >= G / 2) for (int w = bx - G / 2; w < 256; w += G - G / 2) {
            const int c = w >> 2, g = w & 3; LAS bf16_t* vt = (LAS bf16_t*)lds; constexpr int PITCH = 144;
            const int fr = lane & 15, fq = lane >> 4, i0 = wave * 16;
            {
                u32x4 vst[4];
#pragma unroll
                for (int q = 0; q < 4; ++q) { const int ch = tid + q * 512, jr = ch >> 4, dc = (ch & 15) * 8; vst[q] = *(const u32x4*)(GVb + (size_t)(c * 128 + jr) * 512 + g * 128 + dc); }
                const float* wsr = a.w_spatial + (size_t)g * 128 * 128 + (size_t)(i0 + fr) * 128 + fq * 8;
                f32x4 wv[4][2], sv[4][2];
#pragma unroll
                for (int ks = 0; ks < 4; ++ks) { wv[ks][0] = *(const f32x4*)(wsr + ks * 32); wv[ks][1] = *(const f32x4*)(wsr + ks * 32 + 4);
                    const float* sp = SSVP + ((size_t)c * 128 + ks * 32 + fq * 8) * 2; const f32x4 p0 = *(const f32x4*)sp, p1 = *(const f32x4*)(sp + 4), p2 = *(const f32x4*)(sp + 8), p3 = *(const f32x4*)(sp + 12);
                    sv[ks][0] = (f32x4){p0[0] + p0[1], p0[2] + p0[3], p1[0] + p1[1], p1[2] + p1[3]}; sv[ks][1] = (f32x4){p2[0] + p2[1], p2[2] + p2[3], p3[0] + p3[1], p3[2] + p3[3]}; }
                const size_t t = (size_t)c * 128 + i0 + fr;
                const float bs = a.b_spatial[g * 128 + i0 + fr];
                u32x2 ubv[8]; f32x4 sg[8];
#pragma unroll
                for (int n = 0; n < 8; ++n) { ubv[n] = *(const u32x2*)(Ub + t * 512 + g * 128 + n * 16 + fq * 4); sg[n] = *(const f32x4*)(a.sgu_norm + g * 128 + n * 16 + fq * 4); }
#pragma unroll
                for (int q = 0; q < 4; ++q) { const int ch = tid + q * 512, jr = ch >> 4, dc = (ch & 15) * 8; LAS bf16_t* p = vt + dc * PITCH + jr;
                    p[0 * PITCH] = (bf16_t)(vst[q].x & 0xffffu); p[1 * PITCH] = (bf16_t)(vst[q].x >> 16); p[2 * PITCH] = (bf16_t)(vst[q].y & 0xffffu); p[3 * PITCH] = (bf16_t)(vst[q].y >> 16);
                    p[4 * PITCH] = (bf16_t)(vst[q].z & 0xffffu); p[5 * PITCH] = (bf16_t)(vst[q].z >> 16); p[6 * PITCH] = (bf16_t)(vst[q].w & 0xffffu); p[7 * PITCH] = (bf16_t)(vst[q].w >> 16); }
                __syncthreads();
                f32x4 acc[8];
#pragma unroll
                for (int n = 0; n < 8; ++n) acc[n] = (f32x4){0.f, 0.f, 0.f, 0.f};
#pragma unroll
                for (int ks = 0; ks < 4; ++ks) {
                    f32x4 w0 = wv[ks][0], w1 = wv[ks][1];
#pragma unroll
                    for (int e = 0; e < 4; ++e) { w0[e] *= __builtin_amdgcn_rsqf(sv[ks][0][e] * (1.f / 512.f) + EPS); w1[e] *= __builtin_amdgcn_rsqf(sv[ks][1][e] * (1.f / 512.f) + EPS); }
                    const u32x4 aw = pg8::pack8(w0, w1); const bf16x8 wf = *reinterpret_cast<const bf16x8*>(&aw);
#pragma unroll
                    for (int n = 0; n < 8; ++n) { const bf16x8 vf = *(const LAS bf16x8*)(vt + (n * 16 + fr) * PITCH + ks * 32 + fq * 8);
                        acc[n] = __builtin_amdgcn_mfma_f32_16x16x32_bf16(vf, wf, acc[n], 0, 0, 0); }
                }
#pragma unroll
                for (int n = 0; n < 8; ++n) { f32x4 o;
                    o[0] = __uint_as_float(ubv[n].x << 16) * (acc[n][0] * sg[n][0] + bs); o[1] = __uint_as_float(ubv[n].x & 0xffff0000u) * (acc[n][1] * sg[n][1] + bs);
                    o[2] = __uint_as_float(ubv[n].y << 16) * (acc[n][2] * sg[n][2] + bs); o[3] = __uint_as_float(ubv[n].y & 0xffff0000u) * (acc[n][3] * sg[n][3] + bs);
                    *(u32x2*)(XCAT + t * 2048 + 1024 + g * 128 + n * 16 + fq * 4) = pg8::pack4(o); }
                __syncthreads();
            }
        }
    }
    SYNC(3);

    if (IN(4)) { PHASE_ENTER();
        pg8::Gemm g{XCAT, WcatT, DM}; pg8::BranchOrder So; So.init(S, DM, G, bx);
        pg8::EpiBranch E{};
        pg8::gemm_phase(lds, g, So, E, tid);
    }
    SYNC(4);

    if (IN(5)) { PHASE_ENTER();
        pg8::Gemm g{MERGED, WoutT, DM}; pg8::StaticOrder So; So.init(S, DM, DM, G, bx);
        pg8::EpiOut E{xch};
        pg8::gemm_phase(lds, g, So, E, tid, pg8::ResidInit{0});
    }
    SYNC(5);

    if (IN(6)) { PHASE_ENTER();
        pg8::Gemm g{A2, WupT, DM}; pg8::StaticOrder So; So.init(S, DFF, DM, G, bx);
        pg8::EpiUp E; { pg8::Unit u0; E.pm0 = So.next(0, u0) ? u0.pm : -1;
            const int wid_ = tid >> 6; pg8::EpiUp::load_rs((const float*)(ws + WS_SMALL + SM_ROWSSP), (E.pm0 < 0 ? 0 : E.pm0) * 256 + (wid_ >> 2) * 64 + (lane & 15), E.rs0); }
        pg8::gemm_phase(lds, g, So, E, tid);
    }
    SYNC(6);

    if (IN(7)) { PHASE_ENTER();
        pg8::Gemm g{U2, WdownT, DFF}; pg8::StaticOrder So; So.init(S, DM, DFF, G, bx);
        pg8::EpiDown E{};
        pg8::gemm_phase(lds, g, So, E, tid, pg8::ResidInit{1});
    }
#undef IN
#undef SYNC
#undef a
}

extern "C" void kernel_launch(void* const* d_in, const int* in_sizes, int n_in, void* d_out, int out_size, void* d_ws, size_t ws_size, hipStream_t stream) {
    static int grid = 0;
    if (grid == 0) {
        if (n_in != 20 || in_sizes[0] != S * DM || out_size != S * DM || ws_size < WS_END) {
            fprintf(stderr, "kernel_launch: unexpected shapes: n_in %d in0 %d out %d ws %zu (need %zu)\n", n_in, n_in > 0 ? in_sizes[0] : -1, out_size, ws_size, (size_t)WS_END); grid = -1; return; }
        int dev = 0, cus = 0, per_cu = 0;
        hipGetDevice(&dev); hipDeviceGetAttribute(&cus, hipDeviceAttributeMultiprocessorCount, dev);
        if (hipFuncSetAttribute((const void*)fwd_megakernel, hipFuncAttributeMaxDynamicSharedMemorySize, LDS_BYTES) != hipSuccess) { fprintf(stderr, "kernel_launch: hipFuncSetAttribute failed\n"); grid = -1; return; }
        if (hipOccupancyMaxActiveBlocksPerMultiprocessor(&per_cu, (const void*)fwd_megakernel, 512, LDS_BYTES) != hipSuccess || per_cu < 1) { fprintf(stderr, "kernel_launch: occupancy query failed (%d)\n", per_cu); grid = -1; return; }
        grid = cus;
        fprintf(stderr, "kernel_launch: cus %d per_cu %d grid %d\n", cus, per_cu, grid);
    }
    if (grid < 0) return;
    Args a{};
    const float** f = (const float**)&a;
    for (int i = 0; i < 20; ++i) f[i] = (const float*)d_in[i];
    a.out = (float*)d_out; a.ws = (unsigned char*)d_ws;
#ifndef PROBE_A
#define PROBE_A 8
#define PROBE_B 8
#endif
    hipError_t e = hipSuccess;
    for (int li = 0; li < (PROBE_A < 8 || PROBE_B < 8 ? 2 : 1); ++li) {
        a.ph_lo = li == 0 ? 0 : PROBE_B; a.ph_hi = li == 0 ? PROBE_A : 8;
        if (hipMemsetAsync((char*)d_ws + WS_SMALL + SM_BAR, 0, XCD_BAR_WORDS * 4, stream) != hipSuccess) { fprintf(stderr, "kernel_launch: memset failed\n"); return; }
        void* args[] = {&a};
        e = hipLaunchCooperativeKernel((const void*)fwd_megakernel, dim3(grid), dim3(512), args, LDS_BYTES, stream);
        if (e != hipSuccess) break;
    }
    if (e != hipSuccess) fprintf(stderr, "kernel_launch: cooperative launch failed: %s (grid %d)\n", hipGetErrorString(e), grid);
}
```

```cpp
#include <hip/hip_runtime.h>
#include <hip/hip_cooperative_groups.h>
#include <cstdio>
#include <cstdint>
namespace cg = cooperative_groups;

#define LAS __attribute__((address_space(3)))
typedef unsigned short bf16_t;
typedef short bf16x8 __attribute__((ext_vector_type(8)));
typedef short s16x4 __attribute__((ext_vector_type(4)));
typedef float f32x4 __attribute__((ext_vector_type(4)));
typedef float f32x8 __attribute__((ext_vector_type(8)));
typedef float f32x16 __attribute__((ext_vector_type(16)));
typedef unsigned u32x4 __attribute__((ext_vector_type(4)));
typedef unsigned u32x2 __attribute__((ext_vector_type(2)));

constexpr int S = 8192, DM = 2048, INW = 9216, DFF = 8192, MEMT = 256;
constexpr float EPS = 1e-6f;
constexpr size_t MiB = 1024ull * 1024ull;
constexpr size_t WS_WDOWN = 0 * MiB, WS_WUP = 32 * MiB, WS_WOUT = 64 * MiB, WS_WCAT = 72 * MiB, WS_H = 80 * MiB  ,
                 WS_SMALL = 112 * MiB, WS_R0 = 116 * MiB  , WS_WMKV = 152 * MiB, WS_GATES = 156 * MiB,
                 WS_QMRAW = 252 * MiB, WS_VB = 268 * MiB, WS_UB = 272 * MiB, WS_END = 280 * MiB;
constexpr size_t SM_ROWSS = 0, SM_SSV = 32 * 1024, SM_MEMN = 64 * 1024, SM_KMRAW = SM_MEMN + 1 * MiB, SM_KMB = SM_KMRAW + 512 * 1024, SM_VMB = SM_KMB + 256 * 1024, SM_BAR = 2560 * 1024  , SM_CS = SM_BAR + 64 * 1024  , SM_SSQ = 3072 * 1024  ,
                 SM_ROWSSP = 3584 * 1024  , SM_SSVP = 3840 * 1024  ;
constexpr size_t R0_QB = 0  , R0_KB = 24 * MiB, R0_VN = 28 * MiB;
constexpr int LDS_ST_OFF = 133120, LDS_XCH_OFF = 133136  , LDS_BYTES = 133136 + 8192;

struct Args {
    const float *x, *mem, *norm_mix, *w_in, *q_norm, *k_norm, *sgu_norm, *w_spatial, *b_spatial, *mem_norm, *w_mem_kv, *mq_norm, *mk_norm,
                *w_attn_o, *w_gmlp_o, *w_mem_o, *w_out, *norm_ffn, *w_ffn_up, *w_ffn_down;
    float* out; unsigned char* ws; int ph_lo, ph_hi;
};
typedef __attribute__((address_space(4))) const Args CArgs;
#define ARGP() ({ CArgs* p_ = (CArgs*)__builtin_amdgcn_kernarg_segment_ptr(); asm volatile("" : "+s"(p_)); p_; })

typedef __bf16 bf16x2_t __attribute__((ext_vector_type(2)));
typedef float f32x2_t __attribute__((ext_vector_type(2)));
__device__ __forceinline__ unsigned cvt_pk_bf16(float lo, float hi) { const f32x2_t f = {lo, hi}; const bf16x2_t b = __builtin_convertvector(f, bf16x2_t); return __builtin_bit_cast(unsigned, b); }
__device__ __forceinline__ float wave_sum(float v) {
#pragma unroll
    for (int o = 1; o < 64; o <<= 1) v += __shfl_xor(v, o);
    return v;
}
__device__ __forceinline__ float gelu_tanh(float x) {
    const float e = __builtin_amdgcn_exp2f(x * (-2.302208198f - 0.10294324f * x * x));
    return x * __builtin_amdgcn_rcpf(1.0f + e);
}
__device__ __forceinline__ float sigmoidf_(float z) { return __builtin_amdgcn_rcpf(1.0f + __builtin_amdgcn_exp2f(-1.4426950408889634f * z)); }

namespace pg8 {
constexpr int BM = 256, BK = 64, HALF = 128, HTB = HALF * BK * 2, STAGE_BYTES = 8 * HTB, NXCD = 8, WGM = 8;
__device__ __forceinline__ int lds_byte(int r, int c) { const int st = (r >> 4) * 2 + (c >> 5), rr = r & 15, cc = c & 31, ob = rr * 64 + cc * 2; return st * 1024 + (ob ^ (((ob >> 9) & 1) << 5)); }
__device__ __forceinline__ void stage_rc(int b, int& R, int& C) { const int st = b / 1024, sb = b % 1024, swz = sb ^ (((sb >> 9) & 1) << 5); R = (st >> 1) * 16 + swz / 64; C = (st & 1) * 32 + (swz % 64) / 2; }
__device__ __forceinline__ int perm32(int rho) { const int n = rho >> 4, i = rho & 15; return 8 * (i >> 2) + 4 * n + (i & 3); }

struct Unit { int pm, pn, kb, nt, tag, keep; };
struct Gemm { const bf16_t* A; const bf16_t* Bt; int K; };

__device__ __forceinline__ void map_tile(long L, int nM, int nN, int& pm, int& pn) {
    const int nwg = nM * nN; int wgid = (int)L;
    { const int q = nwg / NXCD, r = nwg % NXCD, xcd = wgid % NXCD, off = wgid / NXCD; wgid = (xcd < r ? xcd * (q + 1) : r * (q + 1) + (xcd - r) * q) + off; }
    const int nig = WGM * nN, gid = wgid / nig, fm = gid * WGM, gsz = (nM - fm) < WGM ? (nM - fm) : WGM;
    pm = fm + ((wgid % nig) % gsz); pn = (wgid % nig) / gsz;
}
struct StaticOrder {
    int nM, nN, nwg, G, c, nt;
    __device__ void init(int M, int N, int K, int G_, int c_) { nM = M / BM; nN = N / BM; nwg = nM * nN; G = G_; c = c_; nt = K / BK; }
    __device__ bool next(int i, Unit& u) const {
        const long L = (long)i * G + c; if (L >= nwg) return false;
        map_tile(L, nM, nN, u.pm, u.pn); u.kb = 0; u.nt = nt; u.tag = 0; u.keep = 0; return true;
    }
};
struct InProjOrder : StaticOrder {
    __device__ bool next(int i, Unit& u) const {
        if (!StaticOrder::next(i, u)) return false;
        const unsigned long long T0 = 0x34c0c11c608014bull, T1 = 0x5d65544d24503ceull, T2 = 0x75c6da288658244ull, T3 = 0x8e28607deull;
        const int k = u.pn / 10, j = u.pn - 10 * k; const unsigned long long t = k == 0 ? T0 : (k == 1 ? T1 : (k == 2 ? T2 : T3));
        u.pn = (int)((t >> (6 * j)) & 63ull); return true;
    }
};
struct BranchOrder {
    int nM, nN, nwg, G, c;
    __device__ void init(int M, int N, int G_, int c_) { nM = M / BM; nN = N / BM; nwg = nM * nN; G = G_; c = c_; }
    __device__ bool next(int i, Unit& u) const {
        const int ti = i / 3, br = i - 3 * ti; const long L = (long)ti * G + c; if (L >= nwg) return false;
        map_tile(L, nM, nN, u.pm, u.pn); u.kb = (br == 0 ? 0 : (br == 1 ? 1024 : 1536)) * 2; u.nt = (br == 0 ? 16 : 8); u.tag = br; u.keep = br < 2; return true;
    }
};

struct ZeroInit { __device__ __forceinline__ void operator()(f32x4 (&acc)[2][2][4][2], const Unit&, int, int, int, int) const {
#pragma unroll
    for (int a = 0; a < 2; ++a)
#pragma unroll
        for (int b = 0; b < 2; ++b)
#pragma unroll
            for (int m = 0; m < 4; ++m)
#pragma unroll
                for (int n = 0; n < 2; ++n) acc[a][b][m][n] = (f32x4){0.f, 0.f, 0.f, 0.f}; } };
template <class Epi, class Sched, class Init = ZeroInit>
__device__ __forceinline__ void gemm_phase(LAS unsigned char* lds, const Gemm g, const Sched& S, const Epi& E, const int tid, const Init& I = Init()) {
    const int wid = __builtin_amdgcn_readfirstlane(tid >> 6), lane = tid & 63, wr = wid >> 2, wc = wid & 3, fr = lane & 15, fq = lane >> 4;
    const int K = g.K;
    unsigned voffA[2], voffB[2];
#pragma unroll
    for (int i = 0; i < 2; ++i) { int R, C; stage_rc(tid * 16 + i * 8192, R, C); const int Rb = (R & ~31) + perm32(R & 31);
        voffA[i] = (unsigned)(R * K + C) * 2u; voffB[i] = (unsigned)(Rb * K + C) * 2u; }
    const size_t kstep = (size_t)(BK * 2);
    const size_t hstep = (size_t)HALF * K * 2;
    const size_t tstep = 2 * hstep;
    const unsigned ldsw = (unsigned)wid * 1024u;
    const int aoff = lds_byte(wr * 64 + fr, fq * 8), boff = lds_byte(wc * 32 + fr, fq * 8);
#define PG8_SA(b, h) (((b) * 2 + (h)) * HTB)
#define PG8_SB(b, h) ((4 + (b) * 2 + (h)) * HTB)
#define PG8_STAGE(bufoff, gbase, voff) do { _Pragma("unroll") for (int _i = 0; _i < 2; ++_i) \
        __builtin_amdgcn_global_load_lds((const unsigned*)((const char*)(gbase) + (voff)[_i]), (LAS unsigned*)(lds + (bufoff) + ldsw + _i * 8192), 16, 0, 0); } while (0)
#define PG8_LDA(dst, b, h) do { _Pragma("unroll") for (int m = 0; m < 4; ++m) _Pragma("unroll") for (int k = 0; k < 2; ++k) dst[m][k] = *(const LAS bf16x8*)(lds + PG8_SA(b, h) + aoff + m * 2048 + k * 1024); } while (0)
#define PG8_LDB(dst, b, h) do { _Pragma("unroll") for (int n = 0; n < 2; ++n) _Pragma("unroll") for (int k = 0; k < 2; ++k) dst[n][k] = *(const LAS bf16x8*)(lds + PG8_SB(b, h) + boff + n * 2048 + k * 1024); } while (0)
#define PG8_MMA(ai, bj, At, Bt) do { __builtin_amdgcn_s_setprio(1); _Pragma("unroll") for (int m = 0; m < 4; ++m) _Pragma("unroll") for (int n = 0; n < 2; ++n) _Pragma("unroll") for (int k = 0; k < 2; ++k) \
        acc[ai][bj][m][n] = __builtin_amdgcn_mfma_f32_16x16x32_bf16(Bt[n][k], At[m][k], acc[ai][bj][m][n], 0, 0, 0); __builtin_amdgcn_s_setprio(0); } while (0)
#define PG8_WAIT_V(n) asm volatile("s_waitcnt vmcnt(" #n ")" ::: "memory")
#define PG8_WAIT_L(n) asm volatile("s_waitcnt lgkmcnt(" #n ")" ::: "memory")
#define PG8_BAR __builtin_amdgcn_s_barrier()
#define PG8_SCHED __builtin_amdgcn_sched_barrier(0)
    Unit cur, nxt; int ui = 0;
    if (!S.next(0, cur)) return;
    f32x4 acc[2][2][4][2];
    I(acc, cur, wr, wc, fr, fq);
    bf16x8 At[4][2], B0[2][2], B1[2][2];
    const char* cA = (const char*)g.A + (size_t)cur.pm * tstep + cur.kb; const char* cB = (const char*)g.Bt + (size_t)cur.pn * tstep + cur.kb;
    PG8_STAGE(PG8_SB(0, 0), cB, voffB); PG8_STAGE(PG8_SA(0, 0), cA, voffA); PG8_STAGE(PG8_SB(0, 1), cB + hstep, voffB); PG8_STAGE(PG8_SA(0, 1), cA + hstep, voffA);
    if (wr == 1) PG8_BAR;
    PG8_WAIT_V(4); PG8_BAR;
    PG8_STAGE(PG8_SB(1, 0), cB + kstep, voffB); PG8_STAGE(PG8_SA(1, 0), cA + kstep, voffA); PG8_STAGE(PG8_SB(1, 1), cB + hstep + kstep, voffB);
    PG8_WAIT_V(6); PG8_BAR;
    for (;;) {
        const bool has_next = S.next(ui + 1, nxt);
        const char* nA = has_next ? (const char*)g.A + (size_t)nxt.pm * tstep + nxt.kb : cA; const char* nB = has_next ? (const char*)g.Bt + (size_t)nxt.pn * tstep + nxt.kb : cB;
        const int nt = cur.nt;
        for (int t = 0; t < nt; t += 2) {
            const bool last = (t == nt - 2);
            const char* a1 = cA + (size_t)(t + 1) * kstep;
            const char* a2 = last ? nA : cA + (size_t)(t + 2) * kstep; const char* b2 = last ? nB : cB + (size_t)(t + 2) * kstep;
            const char* a3 = a2 + kstep; const char* b3 = b2 + kstep;
            PG8_LDB(B0, 0, 0); PG8_SCHED; PG8_LDA(At, 0, 0); PG8_STAGE(PG8_SA(1, 1), a1 + hstep, voffA);
            PG8_WAIT_L(8); PG8_BAR; PG8_WAIT_L(0); PG8_MMA(0, 0, At, B0); PG8_BAR; PG8_SCHED;
            PG8_LDB(B1, 0, 1); PG8_STAGE(PG8_SB(0, 0), b2, voffB);
            PG8_BAR; PG8_WAIT_L(0); PG8_MMA(0, 1, At, B1); PG8_BAR;
            PG8_LDA(At, 0, 1); PG8_STAGE(PG8_SA(0, 0), a2, voffA);
            PG8_BAR; PG8_WAIT_L(0); PG8_MMA(1, 0, At, B0); PG8_BAR; PG8_SCHED;
            PG8_STAGE(PG8_SB(0, 1), b2 + hstep, voffB);
            PG8_WAIT_V(6); PG8_BAR; PG8_MMA(1, 1, At, B1); PG8_BAR;
            PG8_LDB(B0, 1, 0); PG8_SCHED; PG8_LDA(At, 1, 0); PG8_STAGE(PG8_SA(0, 1), a2 + hstep, voffA);
            PG8_WAIT_L(8); PG8_BAR; PG8_WAIT_L(0); PG8_MMA(0, 0, At, B0); PG8_BAR; PG8_SCHED;
            PG8_LDB(B1, 1, 1); PG8_STAGE(PG8_SB(1, 0), b3, voffB);
            PG8_BAR; PG8_WAIT_L(0); PG8_MMA(0, 1, At, B1); PG8_BAR;
            PG8_LDA(At, 1, 1); PG8_STAGE(PG8_SA(1, 0), a3, voffA);
            PG8_BAR; PG8_WAIT_L(0); PG8_MMA(1, 0, At, B0); PG8_BAR; PG8_SCHED;
            PG8_STAGE(PG8_SB(1, 1), b3 + hstep, voffB);
            PG8_WAIT_V(6); PG8_BAR; PG8_MMA(1, 1, At, B1); PG8_BAR;
        }
        E(acc, cur, wr, wc, fr, fq);
        if (!has_next) break;
        if (!cur.keep) I(acc, nxt, wr, wc, fr, fq);
        cur = nxt; cA = nA; cB = nB; ++ui;
    }
    PG8_WAIT_V(0);
    if (wr == 0) PG8_BAR;
    PG8_BAR;
#undef PG8_SA
#undef PG8_SB
#undef PG8_STAGE
#undef PG8_LDA
#undef PG8_LDB
#undef PG8_MMA
#undef PG8_WAIT_V
#undef PG8_WAIT_L
#undef PG8_BAR
#undef PG8_SCHED
}

__device__ __forceinline__ u32x4 pack8(f32x4 v0, f32x4 v1) { u32x4 w; w.x = cvt_pk_bf16(v0[0], v0[1]); w.y = cvt_pk_bf16(v0[2], v0[3]); w.z = cvt_pk_bf16(v1[0], v1[1]); w.w = cvt_pk_bf16(v1[2], v1[3]); return w; }

__device__ __forceinline__ u32x2 pack4(f32x4 v) { u32x2 w; w.x = cvt_pk_bf16(v[0], v[1]); w.y = cvt_pk_bf16(v[2], v[3]); return w; }
__device__ __forceinline__ float sumsq8(f32x4 a, f32x4 b) { return (a[0] * a[0] + a[1] * a[1]) + (a[2] * a[2] + a[3] * a[3]) + (b[0] * b[0] + b[1] * b[1]) + (b[2] * b[2] + b[3] * b[3]); }
template <bool GELU = false>
__device__ __forceinline__ void head_ss_exchange(const f32x4 (&acc)[2][2][4][2], LAS float* xch, int wr, int wc, int fr, int fq, float (&tot)[2][4][2]) {
#pragma unroll
    for (int ai = 0; ai < 2; ++ai)
#pragma unroll
        for (int m = 0; m < 4; ++m)
#pragma unroll
            for (int bj = 0; bj < 2; ++bj) { f32x4 a0 = acc[ai][bj][m][0], a1 = acc[ai][bj][m][1];
                if (GELU) {
#pragma unroll
                    for (int j = 0; j < 4; ++j) { a0[j] = gelu_tanh(a0[j]); a1[j] = gelu_tanh(a1[j]); } }
                float ss = sumsq8(a0, a1); ss += __shfl_xor(ss, 16); ss += __shfl_xor(ss, 32);
                if (fq == 0) xch[((wr * 128 + (ai * 4 + m) * 16 + fr) * 2 + bj) * 4 + wc] = ss; }
    asm volatile("s_waitcnt lgkmcnt(0)" ::: "memory"); __builtin_amdgcn_s_barrier(); asm volatile("" ::: "memory");
#pragma unroll
    for (int ai = 0; ai < 2; ++ai)
#pragma unroll
        for (int m = 0; m < 4; ++m)
#pragma unroll
            for (int bj = 0; bj < 2; ++bj) { const f32x4 p = *(const LAS f32x4*)(xch + ((wr * 128 + (ai * 4 + m) * 16 + fr) * 2 + bj) * 4); tot[ai][m][bj] = (p[0] + p[1]) + (p[2] + p[3]); }
}
struct EpiInProj {
    LAS float* xch;
    __device__ __forceinline__ void operator()(const f32x4 (&acc)[2][2][4][2], const Unit& u, int wr, int wc, int fr, int fq) const {
        CArgs* ap = ARGP(); unsigned char* ws = ap->ws; unsigned char* ob = (unsigned char*)ap->out;
        bf16_t* QALL = (bf16_t*)(ob + R0_QB); bf16_t* Kb = (bf16_t*)(ob + R0_KB); bf16_t* GVb = (bf16_t*)(ob + R0_VN);
        bf16_t* Vb = (bf16_t*)(ws + WS_VB); bf16_t* Ub = (bf16_t*)(ws + WS_UB); bf16_t* GATES = (bf16_t*)(ws + WS_GATES);
        float* SSVP = (float*)(ws + WS_SMALL + SM_SSVP); const float* CS = (const float*)(ws + WS_SMALL + SM_CS);
        const float* q_norm = ap->q_norm; const float* k_norm = ap->k_norm; const float* mq_norm = ap->mq_norm;
        const int pn = u.pn; const int row0 = u.pm * BM + wr * 64 + fr, cl = wc * 32 + 8 * fq;
        if (pn < 5) {
            const bool isk = (pn == 4);
            float tot[2][4][2];
            head_ss_exchange(acc, xch, wr, wc, fr, fq, tot);
            const int hf = wc >> 1, f0 = 16 * (wc & 1) + 4 * fq, dh = 64 * hf + f0;
            const float* gn = isk ? k_norm : q_norm;
            const f32x4 g0 = *(const f32x4*)(gn + dh), g1 = *(const f32x4*)(gn + dh + 32);
#pragma unroll
            for (int ai = 0; ai < 2; ++ai) {
                f32x4 csv[4][2];
#pragma unroll
                for (int m = 0; m < 4; ++m) { const int t = row0 + ai * HALF + m * 16; const int pos = hf ? (t & 63) : (t >> 6);
                    const float* csp = CS + (size_t)(pos * 32 + f0) * 2; csv[m][0] = *(const f32x4*)csp; csv[m][1] = *(const f32x4*)(csp + 4); }
#pragma unroll
                for (int m = 0; m < 4; ++m) { const int t = row0 + ai * HALF + m * 16;
                    const f32x4 cs0 = csv[m][0], cs1 = csv[m][1];
                    const f32x4 cc = {cs0[0], cs0[2], cs1[0], cs1[2]}, sn = {cs0[1], cs0[3], cs1[1], cs1[3]};
#pragma unroll
                    for (int bj = 0; bj < 2; ++bj) { f32x4 v0 = acc[ai][bj][m][0], v1 = acc[ai][bj][m][1];
                        { const float r = __builtin_amdgcn_rsqf(tot[ai][m][bj] * (1.f / 128.f) + EPS); v0 *= r; v1 *= r; }
                        const f32x4 y0 = v0 * g0, y1 = v1 * g1;
                        const f32x4 o0 = y0 * cc - y1 * sn, o1 = y1 * cc + y0 * sn;
                        bf16_t* dst = isk ? Kb + (size_t)t * 256 + bj * 128 + dh : QALL + (size_t)t * 1536 + (pn * 2 + bj) * 128 + dh;
                        *(u32x2*)dst = pack4(o0); *(u32x2*)(dst + 32) = pack4(o1); } }
            }
            return;
        }
        if (pn >= 8 && pn < 12) {
            const bool isqm = pn >= 10;
            f32x4 g0 = {1.f, 1.f, 1.f, 1.f}, g1 = g0;
            if (isqm) { g0 = *(const f32x4*)(mq_norm + cl); g1 = *(const f32x4*)(mq_norm + cl + 4); }
            float tot[2][4][2];
            if (isqm) head_ss_exchange<false>(acc, xch, wr, wc, fr, fq, tot); else head_ss_exchange<true>(acc, xch, wr, wc, fr, fq, tot);
#pragma unroll
            for (int ai = 0; ai < 2; ++ai)
#pragma unroll
                for (int m = 0; m < 4; ++m) { const int t = row0 + ai * HALF + m * 16;
#pragma unroll
                    for (int bj = 0; bj < 2; ++bj) { f32x4 v0 = acc[ai][bj][m][0], v1 = acc[ai][bj][m][1];
                        if (isqm) { const float r = __builtin_amdgcn_rsqf(tot[ai][m][bj] * (1.f / 128.f) + EPS);
                            *(u32x4*)(QALL + (size_t)t * 1536 + 1024 + (pn - 10) * 256 + bj * HALF + cl) = pack8(v0 * r * g0, v1 * r * g1); }
                        else {
#pragma unroll
                            for (int j = 0; j < 4; ++j) { v0[j] = gelu_tanh(v0[j]); v1[j] = gelu_tanh(v1[j]); }
                            *(u32x4*)(GVb + (size_t)t * 512 + (pn - 8) * 256 + bj * HALF + cl) = pack8(v0, v1); } }
                    if (!isqm && wc == 0 && fq == 0) SSVP[(size_t)t * 2 + (pn - 8)] = tot[ai][m][0] + tot[ai][m][1]; }
            return;
        }
        int mode, ld, c0; bf16_t* base;
        if (pn == 5)      { base = Vb;    ld = 256;  c0 = 0; mode = 0; }
        else if (pn < 8)  { base = Ub;    ld = 512;  c0 = (pn - 6) * 256; mode = 1; }
        else              { base = GATES; ld = 6144; c0 = (pn - 12) * 256; mode = 2; }
#pragma unroll
        for (int ai = 0; ai < 2; ++ai)
#pragma unroll
            for (int m = 0; m < 4; ++m) { const size_t roff = (size_t)(row0 + ai * HALF + m * 16) * ld + c0 + cl;
#pragma unroll
                for (int bj = 0; bj < 2; ++bj) { f32x4 v0 = acc[ai][bj][m][0], v1 = acc[ai][bj][m][1];
                    if (mode == 1) {
#pragma unroll
                        for (int j = 0; j < 4; ++j) { v0[j] = gelu_tanh(v0[j]); v1[j] = gelu_tanh(v1[j]); } }
                    else if (mode == 2) {
#pragma unroll
                        for (int j = 0; j < 4; ++j) { v0[j] = sigmoidf_(v0[j]); v1[j] = sigmoidf_(v1[j]); } }
                    *(u32x4*)(base + roff + bj * HALF) = pack8(v0, v1); } }
    }
};
struct EpiMemKV {
    LAS float* xch;
    __device__ __forceinline__ void operator()(const f32x4 (&acc)[2][2][4][2], const Unit& u, int wr, int wc, int fr, int fq) const {
        CArgs* ap = ARGP(); unsigned char* ws = ap->ws; bf16_t* KMb = (bf16_t*)(ws + WS_SMALL + SM_KMB); bf16_t* VMb = (bf16_t*)(ws + WS_SMALL + SM_VMB); const float* mk_norm = ap->mk_norm;
        const int pn = u.pn; const int row0 = u.pm * BM + wr * 64 + fr, cl = wc * 32 + 8 * fq;
        float tot[2][4][2];
        if (pn < 2) head_ss_exchange(acc, xch, wr, wc, fr, fq, tot);
        const f32x4 g0 = *(const f32x4*)(mk_norm + cl), g1 = *(const f32x4*)(mk_norm + cl + 4);
#pragma unroll
        for (int ai = 0; ai < 2; ++ai)
#pragma unroll
            for (int m = 0; m < 4; ++m) { const size_t roff = (size_t)(pn & 1) * 65536 + (size_t)(row0 + ai * HALF + m * 16) * 256 + cl;
#pragma unroll
                for (int bj = 0; bj < 2; ++bj) { f32x4 v0 = acc[ai][bj][m][0], v1 = acc[ai][bj][m][1];
                    if (pn < 2) { const float r = __builtin_amdgcn_rsqf(tot[ai][m][bj] * (1.f / 128.f) + EPS); v0 = v0 * r * g0; v1 = v1 * r * g1; *(u32x4*)(KMb + roff + bj * HALF) = pack8(v0, v1); }
                    else { *(u32x4*)(VMb + roff + bj * HALF) = pack8(v0, v1); } } }
    }
};
__device__ __forceinline__ void unpack8(const u32x4 w, f32x4& lo, f32x4& hi) {
    lo[0] = __uint_as_float(w.x << 16); lo[1] = __uint_as_float(w.x & 0xffff0000u); lo[2] = __uint_as_float(w.y << 16); lo[3] = __uint_as_float(w.y & 0xffff0000u);
    hi[0] = __uint_as_float(w.z << 16); hi[1] = __uint_as_float(w.z & 0xffff0000u); hi[2] = __uint_as_float(w.w << 16); hi[3] = __uint_as_float(w.w & 0xffff0000u);
}
struct EpiBranch {
    __device__ __forceinline__ void operator()(f32x4 (&acc)[2][2][4][2], const Unit& u, int wr, int wc, int fr, int fq) const {
        unsigned char* ws = ARGP()->ws; const bf16_t* GATES = (const bf16_t*)(ws + WS_GATES); bf16_t* MERGED = (bf16_t*)(ws + WS_R0);
        const int br = u.tag; const int row0 = u.pm * BM + wr * 64 + fr, col0 = u.pn * BM + wc * 32 + 8 * fq;
        const bf16_t* gp = GATES + (size_t)row0 * 6144 + br * 2048 + col0;
#pragma unroll
        for (int ai = 0; ai < 2; ++ai) {
            u32x4 ga[4][2], gb[4][2];
#pragma unroll
            for (int m = 0; m < 4; ++m)
#pragma unroll
                for (int bj = 0; bj < 2; ++bj) { const bf16_t* p = gp + (size_t)(ai * HALF + m * 16) * 6144 + bj * HALF;
                    ga[m][bj] = *(const u32x4*)p; if (br < 2) gb[m][bj] = *(const u32x4*)(p + 2048); }
#pragma unroll
            for (int m = 0; m < 4; ++m)
#pragma unroll
                for (int bj = 0; bj < 2; ++bj) { f32x4 g0, g1; unpack8(ga[m][bj], g0, g1);
                    if (br < 2) { f32x4 h0, h1; unpack8(gb[m][bj], h0, h1);
#pragma unroll
                        for (int j = 0; j < 4; ++j) { g0[j] *= __builtin_amdgcn_rcpf(h0[j]); g1[j] *= __builtin_amdgcn_rcpf(h1[j]); }
                        acc[ai][bj][m][0] *= g0; acc[ai][bj][m][1] *= g1; }
                    else { *(u32x4*)(MERGED + (size_t)(row0 + ai * HALF + m * 16) * DM + col0 + bj * HALF) = pack8(acc[ai][bj][m][0] * g0, acc[ai][bj][m][1] * g1); } }
        }
    }
};
struct ResidInit {
    int which;
    __device__ __forceinline__ void operator()(f32x4 (&acc)[2][2][4][2], const Unit& u, int wr, int wc, int fr, int fq) const {
        CArgs* ap = ARGP(); const float* R = which ? (const float*)ap->out : ap->x;
        const int row0 = u.pm * BM + wr * 64 + fr, col0 = u.pn * BM + wc * 32 + 8 * fq;
#pragma unroll
        for (int ai = 0; ai < 2; ++ai)
#pragma unroll
            for (int m = 0; m < 4; ++m)
#pragma unroll
                for (int bj = 0; bj < 2; ++bj) { const float* p = R + (size_t)(row0 + ai * HALF + m * 16) * DM + col0 + bj * HALF; acc[ai][bj][m][0] = *(const f32x4*)p; acc[ai][bj][m][1] = *(const f32x4*)(p + 4); }
    }
};
struct EpiOut {
    LAS float* xch;
    __device__ __forceinline__ void operator()(const f32x4 (&acc)[2][2][4][2], const Unit& u, int wr, int wc, int fr, int fq) const {
        CArgs* ap = ARGP(); unsigned char* ws = ap->ws; const float* G = ap->norm_ffn; float* X1 = ap->out; bf16_t* A2 = (bf16_t*)(ws + WS_H); float* ROWSSP = (float*)(ws + WS_SMALL + SM_ROWSSP);
        float tot[2][4][2];
        head_ss_exchange(acc, xch, wr, wc, fr, fq, tot);
        const int row0 = u.pm * BM + wr * 64 + fr, col0 = u.pn * BM + wc * 32 + 8 * fq;
        f32x4 g[2][2];
#pragma unroll
        for (int bj = 0; bj < 2; ++bj) { g[bj][0] = *(const f32x4*)(G + col0 + bj * HALF); g[bj][1] = *(const f32x4*)(G + col0 + bj * HALF + 4); }
#pragma unroll
        for (int ai = 0; ai < 2; ++ai)
#pragma unroll
            for (int m = 0; m < 4; ++m) { const int row = row0 + ai * HALF + m * 16;
#pragma unroll
                for (int bj = 0; bj < 2; ++bj) { const size_t off = (size_t)row * DM + col0 + bj * HALF;
                    const f32x4 v0 = acc[ai][bj][m][0], v1 = acc[ai][bj][m][1];
                    *(f32x4*)(X1 + off) = v0; *(f32x4*)(X1 + off + 4) = v1;
                    *(u32x4*)(A2 + off) = pack8(v0 * g[bj][0], v1 * g[bj][1]); }
                if (wc == 0 && fq == 0) ROWSSP[(size_t)row * 8 + u.pn] = tot[ai][m][0] + tot[ai][m][1]; }
    }
};
struct EpiUp {
    int pm0; float rs0[2][4];
    __device__ static __forceinline__ void load_rs(const float* ROWSSP, int row0, float (&rs)[2][4]) {
        float rsv[2][4];
#pragma unroll
        for (int ai = 0; ai < 2; ++ai)
#pragma unroll
            for (int m = 0; m < 4; ++m) { const float* pp = ROWSSP + (size_t)(row0 + ai * HALF + m * 16) * 8; const f32x4 pa = *(const f32x4*)pp, pb = *(const f32x4*)(pp + 4);
                rsv[ai][m] = ((pa[0] + pa[1]) + (pa[2] + pa[3])) + ((pb[0] + pb[1]) + (pb[2] + pb[3])); }
#pragma unroll
        for (int ai = 0; ai < 2; ++ai)
#pragma unroll
            for (int m = 0; m < 4; ++m) rs[ai][m] = __builtin_amdgcn_rsqf(rsv[ai][m] * (1.0f / DM) + EPS);
    }
    __device__ __forceinline__ void operator()(const f32x4 (&acc)[2][2][4][2], const Unit& u, int wr, int wc, int fr, int fq) const {
        unsigned char* ws = ARGP()->ws; const float* ROWSSP = (const float*)(ws + WS_SMALL + SM_ROWSSP); bf16_t* U2 = (bf16_t*)(ws + WS_R0);
        const int row0 = u.pm * BM + wr * 64 + fr, col0 = u.pn * BM + wc * 32 + 8 * fq;
        float rs[2][4];
        if (u.pm == pm0) {
#pragma unroll
            for (int ai = 0; ai < 2; ++ai)
#pragma unroll
                for (int m = 0; m < 4; ++m) rs[ai][m] = rs0[ai][m];
        } else load_rs(ROWSSP, row0, rs);
#pragma unroll
        for (int ai = 0; ai < 2; ++ai)
#pragma unroll
            for (int m = 0; m < 4; ++m) { const int row = row0 + ai * HALF + m * 16;
#pragma unroll
                for (int bj = 0; bj < 2; ++bj) { f32x4 v0 = acc[ai][bj][m][0] * rs[ai][m], v1 = acc[ai][bj][m][1] * rs[ai][m];
#pragma unroll
                    for (int j = 0; j < 4; ++j) { const float a = fmaxf(v0[j], 0.f), b = fmaxf(v1[j], 0.f); v0[j] = a * a; v1[j] = b * b; }
                    *(u32x4*)(U2 + (size_t)row * DFF + col0 + bj * HALF) = pack8(v0, v1); } }
    }
};
struct EpiDown {
    __device__ __forceinline__ void operator()(const f32x4 (&acc)[2][2][4][2], const Unit& u, int wr, int wc, int fr, int fq) const {
        float* OUT = ARGP()->out;
        const int row0 = u.pm * BM + wr * 64 + fr, col0 = u.pn * BM + wc * 32 + 8 * fq;
#pragma unroll
        for (int ai = 0; ai < 2; ++ai)
#pragma unroll
            for (int m = 0; m < 4; ++m)
#pragma unroll
                for (int bj = 0; bj < 2; ++bj) { float* p = OUT + (size_t)(row0 + ai * HALF + m * 16) * DM + col0 + bj * HALF; *(f32x4*)p = acc[ai][bj][m][0]; *(f32x4*)(p + 4) = acc[ai][bj][m][1]; }
    }
};
}

namespace att {
constexpr int D = 128, NW = 8, QBLK = 32, KVBLK = 64;
constexpr float SCALE = 0.088388347648318440f;
constexpr float THR = 8.f;
constexpr size_t SHM_V = KVBLK * D * 2, SHM_K = KVBLK * D * 2, SHM_ATTN = 2 * SHM_V + 2 * SHM_K + NW * 64 * 4;
#define KSWZ(row, colB) ((row) * 256 + ((colB) ^ (((row) & 7) << 4)))
#define SBAR() __builtin_amdgcn_sched_barrier(0)
__device__ __forceinline__ int crow(int r, int hi) { return (r & 3) + 8 * (r >> 2) + 4 * hi; }
__device__ __forceinline__ void partialSM(f32x16& p0, f32x16& p1, float& m_reg, float& mn, float& alpha) {
  constexpr float C = SCALE * 1.4426950408889634f;
  float pmax = p0[0];
#pragma unroll
  for (int r = 1; r < 16; ++r) pmax = fmaxf(pmax, p0[r]);
#pragma unroll
  for (int r = 0; r < 16; ++r) pmax = fmaxf(pmax, p1[r]);
  { auto rr = __builtin_amdgcn_permlane32_swap(__float_as_uint(pmax), __float_as_uint(pmax), false, false);
    pmax = fmaxf(__uint_as_float(rr[0]), __uint_as_float(rr[1])); }
  if (__builtin_expect(__all(pmax - m_reg <= THR / SCALE), 1)) { mn = m_reg; alpha = 1.f; }
  else { mn = fmaxf(m_reg, pmax); alpha = __builtin_amdgcn_exp2f((m_reg - mn) * C); m_reg = mn; }
  float mnC = -mn * C;
#pragma unroll
  for (int r = 0; r < 16; ++r) p0[r] = fmaf(p0[r], C, mnC);
#pragma unroll
  for (int r = 0; r < 16; ++r) p1[r] = fmaf(p1[r], C, mnC);
#pragma unroll
  for (int r = 0; r < 16; ++r) p0[r] = __builtin_amdgcn_exp2f(p0[r]);
}
__device__ __forceinline__ void finishSM(f32x16& p0, f32x16& p1, float alpha, float& l_reg, bf16x8& pa0, bf16x8& pa1, bf16x8& pa2, bf16x8& pa3) {
#pragma unroll
  for (int r = 0; r < 16; ++r) p1[r] = __builtin_amdgcn_exp2f(p1[r]);
  float ps = 0;
#pragma unroll
  for (int r = 0; r < 16; ++r) ps += p0[r];
#pragma unroll
  for (int r = 0; r < 16; ++r) ps += p1[r];
  { auto rr = __builtin_amdgcn_permlane32_swap(__float_as_uint(ps), __float_as_uint(ps), false, false);
    ps = __uint_as_float(rr[0]) + __uint_as_float(rr[1]); }
  l_reg = l_reg * alpha + ps;
#define PK4(P, BASE, OUT) do { unsigned a0 = cvt_pk_bf16(P[BASE + 0], P[BASE + 1]), a1 = cvt_pk_bf16(P[BASE + 2], P[BASE + 3]);   \
    unsigned b0 = cvt_pk_bf16(P[BASE + 4], P[BASE + 5]), b1 = cvt_pk_bf16(P[BASE + 6], P[BASE + 7]);                              \
    auto r0 = __builtin_amdgcn_permlane32_swap(a0, b0, false, false); auto r1 = __builtin_amdgcn_permlane32_swap(a1, b1, false, false); \
    u32x4 w = {r0[0], r1[0], r0[1], r1[1]}; OUT = *reinterpret_cast<bf16x8*>(&w); } while (0)
  PK4(p0, 0, pa0); PK4(p0, 8, pa1); PK4(p1, 0, pa2); PK4(p1, 8, pa3);
#undef PK4
}
__device__ __forceinline__ void qkt(f32x16& p0, f32x16& p1, const bf16_t* Ks, const bf16x8* qr, int r32, int hi) {
  p0 = f32x16{}; p1 = f32x16{};
#pragma unroll
  for (int d0 = 0; d0 < 8; ++d0) { int cb = (d0 * 16 + hi * 8) * 2;
    bf16x8 b0 = *reinterpret_cast<const bf16x8*>((const char*)Ks + KSWZ(r32, cb));
    bf16x8 b1 = *reinterpret_cast<const bf16x8*>((const char*)Ks + KSWZ(32 + r32, cb));
    p0 = __builtin_amdgcn_mfma_f32_32x32x16_bf16(b0, qr[d0], p0, 0, 0, 0);
    p1 = __builtin_amdgcn_mfma_f32_32x32x16_bf16(b1, qr[d0], p1, 0, 0, 0); }
}
__device__ __forceinline__ int v_st(int k, int c) { const int kk = (k & ~0xC) | ((k & 4) << 1) | ((k & 8) >> 1); return ((kk >> 3) * 4 + (c >> 5)) * 512 + ((kk & 7) * 32 + (c & 31)) * 2; }
__device__ __forceinline__ int v_rd_base(int lane) { return ((lane & 3) << 3) | (((lane >> 2) & 3) << 6) | (((lane >> 4) & 1) << 5) | (((lane >> 5) & 1) << 8); }
constexpr int v_rd_off(int d0, int ks, int half) { return d0 * 512 + ks * 4096 + half * 2048; }
template <int OFF> __device__ __forceinline__ s16x4 tr_read(int vb) {
  s16x4 r; asm volatile("ds_read_b64_tr_b16 %0, %1 offset:%2" : "=&v"(r) : "v"(vb), "i"(OFF) : "memory"); return r;
}
template <int D0> __device__ __forceinline__ void pv_one(f32x16& od, int vb, bf16x8 pa0, bf16x8 pa1, bf16x8 pa2, bf16x8 pa3) {
  const s16x4 l0 = tr_read<v_rd_off(D0, 0, 0)>(vb), h0 = tr_read<v_rd_off(D0, 0, 1)>(vb), l1 = tr_read<v_rd_off(D0, 1, 0)>(vb), h1 = tr_read<v_rd_off(D0, 1, 1)>(vb);
  const s16x4 l2 = tr_read<v_rd_off(D0, 2, 0)>(vb), h2 = tr_read<v_rd_off(D0, 2, 1)>(vb), l3 = tr_read<v_rd_off(D0, 3, 0)>(vb), h3 = tr_read<v_rd_off(D0, 3, 1)>(vb);
  asm volatile("s_waitcnt lgkmcnt(0)" ::: "memory"); SBAR();
#define PK(L, H) (bf16x8){L[0], L[1], L[2], L[3], H[0], H[1], H[2], H[3]}
  od = __builtin_amdgcn_mfma_f32_32x32x16_bf16(pa0, PK(l0, h0), od, 0, 0, 0);
  od = __builtin_amdgcn_mfma_f32_32x32x16_bf16(pa1, PK(l1, h1), od, 0, 0, 0);
  od = __builtin_amdgcn_mfma_f32_32x32x16_bf16(pa2, PK(l2, h2), od, 0, 0, 0);
  od = __builtin_amdgcn_mfma_f32_32x32x16_bf16(pa3, PK(l3, h3), od, 0, 0, 0);
#undef PK
}
#define PV_BLOCK_READS(D0) \
  const s16x4 l0_##D0 = tr_read<v_rd_off(D0, 0, 0)>(vb), h0_##D0 = tr_read<v_rd_off(D0, 0, 1)>(vb), l1_##D0 = tr_read<v_rd_off(D0, 1, 0)>(vb), h1_##D0 = tr_read<v_rd_off(D0, 1, 1)>(vb); \
  const s16x4 l2_##D0 = tr_read<v_rd_off(D0, 2, 0)>(vb), h2_##D0 = tr_read<v_rd_off(D0, 2, 1)>(vb), l3_##D0 = tr_read<v_rd_off(D0, 3, 0)>(vb), h3_##D0 = tr_read<v_rd_off(D0, 3, 1)>(vb);
#define PKV(L, H) (bf16x8){L[0], L[1], L[2], L[3], H[0], H[1], H[2], H[3]}
#define PV_BLOCK_MMA(D0) \
  asm volatile("s_waitcnt lgkmcnt(0)" ::: "memory"); SBAR(); \
  o[D0] = __builtin_amdgcn_mfma_f32_32x32x16_bf16(pa0, PKV(l0_##D0, h0_##D0), o[D0], 0, 0, 0); \
  o[D0] = __builtin_amdgcn_mfma_f32_32x32x16_bf16(pa1, PKV(l1_##D0, h1_##D0), o[D0], 0, 0, 0); \
  o[D0] = __builtin_amdgcn_mfma_f32_32x32x16_bf16(pa2, PKV(l2_##D0, h2_##D0), o[D0], 0, 0, 0); \
  o[D0] = __builtin_amdgcn_mfma_f32_32x32x16_bf16(pa3, PKV(l3_##D0, h3_##D0), o[D0], 0, 0, 0);
#define SGB4(NV) do { __builtin_amdgcn_sched_group_barrier(0x008, 1, 0); __builtin_amdgcn_sched_group_barrier(0x002, NV, 0); __builtin_amdgcn_sched_group_barrier(0x008, 1, 0); __builtin_amdgcn_sched_group_barrier(0x002, NV, 0); \
    __builtin_amdgcn_sched_group_barrier(0x008, 1, 0); __builtin_amdgcn_sched_group_barrier(0x002, NV, 0); __builtin_amdgcn_sched_group_barrier(0x008, 1, 0); __builtin_amdgcn_sched_group_barrier(0x002, NV, 0); } while (0)
__device__ __forceinline__ void pv_sm(f32x16* o, int vb, bf16x8 pa0, bf16x8 pa1, bf16x8 pa2, bf16x8 pa3, f32x16& p0, f32x16& p1, float& m_reg, float& mn, float& alpha) {
  constexpr float C = SCALE * 1.4426950408889634f;
  { PV_BLOCK_READS(0)
    PV_BLOCK_MMA(0)
    float pmax = p0[0];
#pragma unroll
    for (int r = 1; r < 16; ++r) pmax = fmaxf(pmax, p0[r]);
    mn = pmax;
    SGB4(2); }
  { PV_BLOCK_READS(1)
    PV_BLOCK_MMA(1)
    float pmax = mn;
#pragma unroll
    for (int r = 0; r < 16; ++r) pmax = fmaxf(pmax, p1[r]);
    mn = pmax;
    SGB4(2); }
  { auto rr = __builtin_amdgcn_permlane32_swap(__float_as_uint(mn), __float_as_uint(mn), false, false);
    const float pmax = fmaxf(__uint_as_float(rr[0]), __uint_as_float(rr[1]));
    const bool keep = __all(pmax - m_reg <= THR / SCALE);
    mn = keep ? m_reg : fmaxf(m_reg, pmax); alpha = __builtin_amdgcn_exp2f((m_reg - mn) * C); m_reg = mn; }
  { PV_BLOCK_READS(2)
    PV_BLOCK_MMA(2)
    const float mnC = -mn * C;
#pragma unroll
    for (int r = 0; r < 16; ++r) p0[r] = fmaf(p0[r], C, mnC);
#pragma unroll
    for (int r = 0; r < 16; ++r) p1[r] = fmaf(p1[r], C, mnC);
    SGB4(8); }
  { PV_BLOCK_READS(3)
    PV_BLOCK_MMA(3)
#pragma unroll
    for (int r = 0; r < 16; ++r) p0[r] = __builtin_amdgcn_exp2f(p0[r]);
    SGB4(4); }
}
#undef SGB4
#undef PV_BLOCK_READS
#undef PV_BLOCK_MMA
#undef PKV
__device__ __forceinline__ void pv_d0(f32x16* o, int vb, bf16x8 pa0, bf16x8 pa1, bf16x8 pa2, bf16x8 pa3) {
  pv_one<0>(o[0], vb, pa0, pa1, pa2, pa3); pv_one<1>(o[1], vb, pa0, pa1, pa2, pa3); pv_one<2>(o[2], vb, pa0, pa1, pa2, pa3); pv_one<3>(o[3], vb, pa0, pa1, pa2, pa3);
}
template <int LDQ, int LDK, int LDO>
__device__ __forceinline__ void attn_dense_body(const bf16_t* __restrict__ Qb, const bf16_t* __restrict__ Kh, const bf16_t* __restrict__ Vh,
                                                bf16_t* __restrict__ Ob, int seq, char* lds, const float* __restrict__ ssq, const int tid) {
  const int wid = tid >> 6, lane = tid & 63, r32 = lane & 31, hi = lane >> 5;
  bf16_t* V_lds = (bf16_t*)lds; bf16_t* K_lds = (bf16_t*)(lds + 2 * SHM_V);
  float* ws = (float*)(lds + 2 * SHM_V + 2 * SHM_K) + wid * 64; float* li_l = ws; float* al_l = ws + 32;
  float m_reg = -1e30f, l_reg = 0; f32x16 o[4] = {}; bf16x8 qr[8];
  const bf16_t* Qw = Qb + (long)(wid * QBLK + r32) * LDQ + hi * 8;
  const float rq = __builtin_amdgcn_rsqf(ssq[(wid * QBLK + r32) * 16] * (1.f / 128.f) + EPS);
#pragma unroll
  for (int d0 = 0; d0 < 8; ++d0) { const u32x4 w = *reinterpret_cast<const u32x4*>(Qw + d0 * 16); f32x4 lo, hi2; pg8::unpack8(w, lo, hi2);
    const u32x4 o = pg8::pack8(lo * rq, hi2 * rq); qr[d0] = *reinterpret_cast<const bf16x8*>(&o); }
  const int sr = tid >> 4, sc = (tid & 15) * 8, vst0 = v_st(sr, sc), vst1 = v_st(32 + sr, sc);
  const int vb0 = (int)(uintptr_t)V_lds + v_rd_base(lane);
  struct { bf16x8 vs0, vs1, ks0, ks1; } sr_[2];
#define SLOAD(i, k0) do { sr_[i].vs0 = *reinterpret_cast<const bf16x8*>(&Vh[(long)((k0) + sr) * LDK + sc]); sr_[i].vs1 = *reinterpret_cast<const bf16x8*>(&Vh[(long)((k0) + 32 + sr) * LDK + sc]); \
    sr_[i].ks0 = *reinterpret_cast<const bf16x8*>(&Kh[(long)((k0) + sr) * LDK + sc]); sr_[i].ks1 = *reinterpret_cast<const bf16x8*>(&Kh[(long)((k0) + 32 + sr) * LDK + sc]); } while (0)
#define SWRITE(b, i) do { *(bf16x8*)((char*)V_lds + (b) * SHM_V + vst0) = sr_[i].vs0;          \
    *(bf16x8*)((char*)V_lds + (b) * SHM_V + vst1) = sr_[i].vs1; int kc = sc * 2;               \
    *(bf16x8*)((char*)K_lds + (b) * SHM_K + KSWZ(sr, kc)) = sr_[i].ks0;                       \
    *(bf16x8*)((char*)K_lds + (b) * SHM_K + KSWZ(32 + sr, kc)) = sr_[i].ks1; } while (0)
#define SWAIT() asm volatile("s_waitcnt vmcnt(4)" ::: "memory")
#define RESC(a) do { if (__any((a) < 1.f)) { if (hi == 0) al_l[r32] = (a); asm volatile("s_waitcnt lgkmcnt(0)" ::: "memory"); \
    _Pragma("unroll") for (int d = 0; d < 4; ++d) _Pragma("unroll") for (int r = 0; r < 16; ++r) o[d][r] *= al_l[crow(r, hi)]; } } while (0)
  f32x16 pA0, pA1, pB0, pB1; float mnA, mnB, alA, alB; bf16x8 pa0, pa1, pa2, pa3; const int NT = seq / KVBLK;
  constexpr int SE = 0, SO = 1;
  SLOAD(SE, 0); asm volatile("s_waitcnt vmcnt(0)" ::: "memory"); SWRITE(0, SE); __syncthreads();
  qkt(pA0, pA1, K_lds, qr, r32, hi); partialSM(pA0, pA1, m_reg, mnA, alA);
  SLOAD(SO, KVBLK); if (2 < NT) SLOAD(SE, 2 * KVBLK);
  SWAIT(); SWRITE(1, SO); __syncthreads();
  for (int j = 1; j + 1 < NT; j += 2) {
    SBAR(); qkt(pB0, pB1, (bf16_t*)((char*)K_lds + SHM_K), qr, r32, hi);
    finishSM(pA0, pA1, alA, l_reg, pa0, pa1, pa2, pa3); SBAR();
    SLOAD(SO, (j + 2) * KVBLK); SBAR();
    pv_sm(o, vb0, pa0, pa1, pa2, pa3, pB0, pB1, m_reg, mnB, alB);
    __syncthreads(); SWAIT(); SWRITE(0, SE);
    RESC(alB); __syncthreads();
    SBAR(); qkt(pA0, pA1, K_lds, qr, r32, hi);
    finishSM(pB0, pB1, alB, l_reg, pa0, pa1, pa2, pa3); SBAR();
    if (j + 3 < NT) SLOAD(SE, (j + 3) * KVBLK); SBAR();
    pv_sm(o, vb0 + (int)SHM_V, pa0, pa1, pa2, pa3, pA0, pA1, m_reg, mnA, alA);
    __syncthreads(); SWAIT(); SWRITE(1, SO);
    RESC(alA); __syncthreads();
  }
  SBAR(); qkt(pB0, pB1, (bf16_t*)((char*)K_lds + SHM_K), qr, r32, hi);
  finishSM(pA0, pA1, alA, l_reg, pa0, pa1, pa2, pa3); SBAR();
  pv_sm(o, vb0, pa0, pa1, pa2, pa3, pB0, pB1, m_reg, mnB, alB);
  __syncthreads(); RESC(alB);
  finishSM(pB0, pB1, alB, l_reg, pa0, pa1, pa2, pa3); SBAR();
  pv_d0(o, vb0 + (int)SHM_V, pa0, pa1, pa2, pa3);
  if (hi == 0) li_l[r32] = l_reg; asm volatile("s_waitcnt lgkmcnt(0)" ::: "memory");
  float rli[16];
#pragma unroll
  for (int r = 0; r < 16; ++r) rli[r] = __builtin_amdgcn_rcpf(li_l[crow(r, hi)]);
  bf16_t* Ow = Ob + (long)(wid * QBLK) * LDO;
#pragma unroll
  for (int r = 0; r < 16; ++r) { int orow = crow(r, hi);
#pragma unroll
    for (int d0 = 0; d0 < 4; ++d0) Ow[(long)orow * LDO + d0 * 32 + r32] = (bf16_t)(cvt_pk_bf16(o[d0][r] * rli[r], 0.f) & 0xffffu); }
  __syncthreads();
#undef SLOAD
#undef SWRITE
#undef SWAIT
#undef RESC
}
}

__device__ __forceinline__ void transpose_item(const float* __restrict__ W, int N, bf16_t* __restrict__ WT, int ldt, int koff, LAS float* scr, int kb, int nb, int lane, int nperm) {
    const int k0 = 64 * kb, n0 = 64 * nb, lr = lane >> 4, lc = (lane & 15) * 4;
    const float* p = W + (size_t)(k0 + lr) * N + n0 + lc; const size_t step = (size_t)4 * N;
    f32x4 v[16];
#pragma unroll
    for (int i = 0; i < 16; ++i) { v[i] = *(const f32x4*)p; p += step; }
#pragma unroll
    for (int i = 0; i < 16; ++i) { LAS float* d = scr + (4 * i + lr) * 65 + lc; d[0] = v[i][0]; d[1] = v[i][1]; d[2] = v[i][2]; d[3] = v[i][3]; }
    asm volatile("s_waitcnt lgkmcnt(0)" ::: "memory");
    const int c = lane & 7;
#pragma unroll
    for (int j = 0; j < 8; ++j) { const int n = (lane >> 3) + 8 * j; const LAS float* s = scr + (8 * c) * 65 + n;
        u32x4 o; o.x = cvt_pk_bf16(s[0 * 65], s[1 * 65]); o.y = cvt_pk_bf16(s[2 * 65], s[3 * 65]); o.z = cvt_pk_bf16(s[4 * 65], s[5 * 65]); o.w = cvt_pk_bf16(s[6 * 65], s[7 * 65]);
        const int dn = (n0 < nperm) ? n0 + 8 * ((n & 31) >> 2) + 4 * (n >> 5) + (n & 3) : n0 + n;
        *(u32x4*)(WT + (size_t)dn * ldt + koff + k0 + 8 * c) = o; }
    asm volatile("s_waitcnt lgkmcnt(0)" ::: "memory");
}
__device__ __forceinline__ void rms_row_to_bf16(const float* __restrict__ xrow, const float* __restrict__ g, bf16_t* __restrict__ orow, int lane) {
    const f32x4* xr = (const f32x4*)xrow + lane; const f32x4* gr = (const f32x4*)g + lane;
    f32x4 v[8]; float s = 0.f;
#pragma unroll
    for (int j = 0; j < 8; ++j) { v[j] = xr[64 * j]; s += (v[j][0] * v[j][0] + v[j][1] * v[j][1]) + (v[j][2] * v[j][2] + v[j][3] * v[j][3]); }
    const float r = __builtin_amdgcn_rsqf(wave_sum(s) * (1.f / DM) + EPS);
    u32x2* o8 = (u32x2*)orow + lane;
#pragma unroll
    for (int j = 0; j < 8; ++j) { const f32x4 gg = gr[64 * j]; u32x2 w; w.x = cvt_pk_bf16(v[j][0] * r * gg[0], v[j][1] * r * gg[1]); w.y = cvt_pk_bf16(v[j][2] * r * gg[2], v[j][3] * r * gg[3]); o8[64 * j] = w; }
}
__device__ __forceinline__ void sincos_pos(float af, float& s, float& c) {
    const double a = (double)af;
    const double n = __builtin_rint(a * 0.63661977236758134308);
    const double r = __builtin_fma(-n, 1.57079632679489661923, a) - n * 6.12323399573676603587e-17;
    const double r2 = r * r;
    double ps = -2.5052108385441718775e-08; ps = ps * r2 + 2.7557319223985890653e-06; ps = ps * r2 - 1.9841269841269841270e-04; ps = ps * r2 + 8.3333333333333333333e-03; ps = ps * r2 - 1.6666666666666666667e-01;
    const double sr = r + r * r2 * ps;
    double pc = 2.0876756987868098979e-09; pc = pc * r2 - 2.7557319223985890653e-07; pc = pc * r2 + 2.4801587301587301587e-05; pc = pc * r2 - 1.3888888888888888889e-03; pc = pc * r2 + 4.1666666666666666667e-02; pc = pc * r2 - 0.5;
    const double cr = 1.0 + r2 * pc;
    const int q = ((int)n) & 3;
    const double ss = (q & 1) ? cr : sr, cc = (q & 1) ? sr : cr;
    s = (float)((q & 2) ? -ss : ss); c = (float)(((q + 1) & 2) ? -cc : cc);
}

constexpr int I_IN = (DM / 64) * (INW / 64), I_MKV = (DM / 64) * (1024 / 64), I_AO = (1024 / 64) * (DM / 64), I_GO = (512 / 64) * (DM / 64), I_MO = I_GO,
              I_OUT = (DM / 64) * (DM / 64), I_UP = (DM / 64) * (DFF / 64), I_DN = (DFF / 64) * (DM / 64);
constexpr int IT_EARLY = I_IN + I_MKV, NITEMS = IT_EARLY + I_AO + I_GO + I_MO + I_OUT + I_UP + I_DN, IT_P0 = IT_EARLY;

#define XB_TMO      128
#define XB_XCNT(j)  (256  + 64 * (j))
#define XB_XSUB(j)  (1280 + 64 * (j))
#define XB_XGEN(j)  (2304 + 64 * (j))
#define XB_TOP      3328
#define XB_TOPGEN   3392
#define XCD_BAR_WORDS 3456
#define XB_SPIN_CAP (1u << 18)
__device__ __forceinline__ unsigned xb_ld(unsigned* p)              { return __hip_atomic_load(p, __ATOMIC_RELAXED, __HIP_MEMORY_SCOPE_AGENT); }
__device__ __forceinline__ unsigned xb_add(unsigned* p, unsigned v) { return __hip_atomic_fetch_add(p, v, __ATOMIC_RELAXED, __HIP_MEMORY_SCOPE_AGENT); }
__device__ __forceinline__ unsigned xb_xcc_id() { return (unsigned)__builtin_amdgcn_s_getreg((3 << 11) | 20) & 0xFu; }
#define XB_SPIN(cond, bar) do { unsigned _sp = 0; while (cond) { __builtin_amdgcn_s_sleep(1); \
    if ((++_sp & 255u) == 0u) { if (xb_ld(&(bar)[XB_TMO])) break; if (_sp > XB_SPIN_CAP) { atomicAdd(&(bar)[XB_TMO], 1u); break; } } } } while (0)
struct XcdBarrier { unsigned* bar; unsigned x; volatile LAS unsigned* st; };
__device__ __forceinline__ XcdBarrier xcd_barrier_post(unsigned* bar, volatile LAS unsigned* st) {
    XcdBarrier b; b.bar = bar; b.x = xb_xcc_id(); b.st = st;
    if (threadIdx.x == 0) (void)xb_add(&bar[XB_XCNT(b.x)], 1u);
    return b;
}
__device__ __forceinline__ void xcd_barrier_complete(unsigned* bar, unsigned x, unsigned& nloc, unsigned& nx) {
    const unsigned G = gridDim.x * gridDim.y * gridDim.z;
    unsigned sum, cnt, mine, sp = 0u;
    for (;;) {
        sum = 0u; cnt = 0u; mine = 0u;
#pragma unroll
        for (unsigned j = 0; j < 16; ++j) { const unsigned c = xb_ld(&bar[XB_XCNT(j)]); sum += c; cnt += (c > 0u) ? 1u : 0u; mine = (j == x) ? c : mine; }
        if (sum == G) break;
        __builtin_amdgcn_s_sleep(1);
        if ((++sp & 255u) == 0u) { if (xb_ld(&bar[XB_TMO])) break; if (sp > XB_SPIN_CAP) { atomicAdd(&bar[XB_TMO], 1u); break; } }
    }
    nloc = mine > 0u ? mine : 1u; nx = cnt > 0u ? cnt : 1u;
}
__device__ __forceinline__ void xcd_barrier(const XcdBarrier& b, const int wave) {
    asm volatile("s_waitcnt vmcnt(0)" ::: "memory");
    __syncthreads();
    if (wave == 0 && __builtin_amdgcn_mbcnt_lo(~0u, 0u) == 0u) {
        unsigned* bar = b.bar;
        __builtin_amdgcn_s_waitcnt(0);
        unsigned nloc = b.st[0], nx = b.st[1];
        if (nloc == 0u) { xcd_barrier_complete(bar, b.x, nloc, nx); b.st[0] = nloc; b.st[1] = nx; }
        const unsigned old = xb_add(&bar[XB_XSUB(b.x)], 1u);
        const unsigned gen = old / nloc;
        if (old + 1u == (gen + 1u) * nloc) {
            __builtin_amdgcn_fence(__ATOMIC_RELEASE, "agent");
            asm volatile("s_waitcnt vmcnt(0)" ::: "memory");
            const unsigned og = xb_add(&bar[XB_TOP], 1u);
            const unsigned tg = og / nx;
            if (og + 1u == (tg + 1u) * nx) xb_add(&bar[XB_TOPGEN], 1u);
            else XB_SPIN(xb_ld(&bar[XB_TOPGEN]) == tg, bar);
            __builtin_amdgcn_fence(__ATOMIC_ACQUIRE, "agent");
            xb_add(&bar[XB_XGEN(b.x)], 1u);
            asm volatile("s_waitcnt vmcnt(0)" ::: "memory");
        } else {
            XB_SPIN(xb_ld(&bar[XB_XGEN(b.x)]) == gen, bar);
            __builtin_amdgcn_fence(__ATOMIC_ACQUIRE, "agent");
            asm volatile("s_waitcnt vmcnt(0)" ::: "memory");
        }
    }
    __syncthreads();
}

__global__ void __launch_bounds__(512, 1) fwd_megakernel(Args a_unused) {
    extern __shared__ __attribute__((aligned(16))) unsigned char lds_raw[];
    LAS unsigned char* lds = (LAS unsigned char*)lds_raw;
    const int tid0 = threadIdx.x, wave = __builtin_amdgcn_readfirstlane(tid0 >> 6);
    const int G = gridDim.x, bx = blockIdx.x;
    const int gw = bx * 8 + wave, NGW = G * 8;
#define a (*ap)
#define PHASE_ENTER() int tid_; asm volatile("v_mbcnt_lo_u32_b32 %0, -1, 0\n\tv_mbcnt_hi_u32_b32 %0, -1, %0\n\tv_lshl_add_u32 %0, %1, 6, %0" : "=&v"(tid_) : "s"(wave));   \
    const int tid = tid_ & 511, lane = tid & 63; (void)lane; \
    CArgs* ap = ARGP(); unsigned char* ws = a.ws; \
    bf16_t* WdownT = (bf16_t*)(ws + WS_WDOWN); bf16_t* WupT = (bf16_t*)(ws + WS_WUP); bf16_t* WoutT = (bf16_t*)(ws + WS_WOUT); bf16_t* WcatT = (bf16_t*)(ws + WS_WCAT); \
    bf16_t* Hb = (bf16_t*)(ws + WS_H); bf16_t* XCAT = Hb; bf16_t* A2 = Hb; \
    float* SSVP = (float*)(ws + WS_SMALL + SM_SSVP); float* SSQ = (float*)(ws + WS_SMALL + SM_SSQ); float* CS = (float*)(ws + WS_SMALL + SM_CS); bf16_t* MEMN = (bf16_t*)(ws + WS_SMALL + SM_MEMN); \
    bf16_t* KMb = (bf16_t*)(ws + WS_SMALL + SM_KMB); bf16_t* VMb = (bf16_t*)(ws + WS_SMALL + SM_VMB); \
    bf16_t* WinT = (bf16_t*)(ws + WS_R0); bf16_t* Qb = (bf16_t*)((unsigned char*)a.out + R0_QB); bf16_t* Kb = (bf16_t*)((unsigned char*)a.out + R0_KB); bf16_t* GVb = (bf16_t*)((unsigned char*)a.out + R0_VN); \
    bf16_t* MERGED = (bf16_t*)(ws + WS_R0); bf16_t* U2 = (bf16_t*)(ws + WS_R0); \
    bf16_t* WmkvT = (bf16_t*)(ws + WS_WMKV); bf16_t* GATES = (bf16_t*)(ws + WS_GATES); \
    bf16_t* Vb = (bf16_t*)(ws + WS_VB); bf16_t* Ub = (bf16_t*)(ws + WS_UB); \
    LAS float* xch = (LAS float*)(lds + LDS_XCH_OFF);
    const int lo = ((CArgs*)__builtin_amdgcn_kernarg_segment_ptr())->ph_lo, hi = ((CArgs*)__builtin_amdgcn_kernarg_segment_ptr())->ph_hi;
#ifndef PHASE_MASK
#define PHASE_MASK 0xff
#endif
#define IN(k) (((PHASE_MASK >> (k)) & 1) && lo <= (k) && (k) < hi)
    volatile LAS unsigned* xb_st = (volatile LAS unsigned*)(lds + LDS_ST_OFF);
    if (tid0 == 0) { xb_st[0] = 0u; xb_st[1] = 0u; }
    __syncthreads();
    const XcdBarrier xbar = xcd_barrier_post((unsigned*)(((CArgs*)__builtin_amdgcn_kernarg_segment_ptr())->ws + WS_SMALL + SM_BAR), xb_st);
#define SYNC(k) do { if (IN(k)) xcd_barrier(xbar, wave); } while (0)

    if (IN(0)) { PHASE_ENTER();
        for (int i = bx * 512 + tid; i < S * 4; i += G * 512) ((f32x4*)SSQ)[i] = (f32x4){127.999872f, 127.999872f, 127.999872f, 127.999872f};
        for (int i = bx * 512 + tid; i < 128 * 32; i += G * 512) {
            const int pos = i >> 5, f = i & 31; float sn, cs; sincos_pos((float)pos * __builtin_amdgcn_exp2f((float)f * (-13.287712379549449f / 32.0f)), sn, cs);
            CS[2 * i] = cs; CS[2 * i + 1] = sn; }
        LAS float* scr = (LAS float*)(lds + wave * 16640);
#define TRANSPOSE_ITEMS(IT0, IT1, W0, NW_) \
        for (int it = (IT0) + (W0); it < (IT1); it += (NW_)) { \
            int r = it; const float* W; bf16_t* WT; int N, ldt, koff, nperm = 0; \
            if (r < I_IN) { W = a.w_in; N = INW; WT = WinT; ldt = DM; koff = 0; nperm = 1280; } \
            else if ((r -= I_IN) < I_MKV) { W = a.w_mem_kv; N = 1024; WT = WmkvT; ldt = DM; koff = 0; } \
            else if ((r -= I_MKV) < I_AO) { W = a.w_attn_o; N = DM; WT = WcatT; ldt = DM; koff = 0; } \
            else if ((r -= I_AO) < I_GO) { W = a.w_gmlp_o; N = DM; WT = WcatT; ldt = DM; koff = 1024; } \
            else if ((r -= I_GO) < I_MO) { W = a.w_mem_o; N = DM; WT = WcatT; ldt = DM; koff = 1536; } \
            else if ((r -= I_MO) < I_OUT) { W = a.w_out; N = DM; WT = WoutT; ldt = DM; koff = 0; } \
            else if ((r -= I_OUT) < I_UP) { W = a.w_ffn_up; N = DFF; WT = WupT; ldt = DM; koff = 0; } \
            else { r -= I_UP; W = a.w_ffn_down; N = DM; WT = WdownT; ldt = DFF; koff = 0; } \
              \
            const int nbk = N >> 6, g8 = 8 * nbk, kb8 = r / g8, rem = r - kb8 * g8; \
            transpose_item(W, N, WT, ldt, koff, scr, kb8 * 8 + (rem & 7), rem >> 3, lane, nperm); \
        }
        TRANSPOSE_ITEMS(0, IT_P0, gw, NGW)
        for (int m = gw; m < S + MEMT; m += NGW) {
            if (m < S) rms_row_to_bf16(a.x + (size_t)m * DM, a.norm_mix, Hb + (size_t)m * DM, lane);
            else rms_row_to_bf16(a.mem + (size_t)(m - S) * DM, a.mem_norm, MEMN + (size_t)(m - S) * DM, lane);
        }
        __syncthreads();
    }
    SYNC(0);

    if (IN(1)) { PHASE_ENTER();
        { pg8::Gemm g{Hb, WinT, DM}; pg8::InProjOrder So; So.init(S, INW, DM, G, bx);
          pg8::EpiInProj E{xch};
          pg8::gemm_phase(lds, g, So, E, tid); }
        { pg8::Gemm g{MEMN, WmkvT, DM}; pg8::StaticOrder So; So.init(MEMT, 1024, DM, G, (bx + G / 2) % G);
          pg8::EpiMemKV E{xch};
          pg8::gemm_phase(lds, g, So, E, tid); }
        if (bx >= G / 2 + 4) {
            LAS float* scr = (LAS float*)(lds + wave * 16640);
            TRANSPOSE_ITEMS(IT_P0, NITEMS, (bx - G / 2 - 4) * 8 + wave, (G - G / 2 - 4) * 8)
            __syncthreads();
        }
    }
    SYNC(1);


    if (IN(3)) { PHASE_ENTER();
#ifndef P3_MASK
#define P3_MASK 7
#endif
        if (P3_MASK & 1) for (int w = bx; w < 384; w += G) {
            const bool self = w < 256; const int h = self ? (w & 7) : (w & 3), qb = self ? (w >> 3) : ((w - 256) >> 2);
            const bf16_t* Qp = Qb + (size_t)qb * 256 * 1536 + (self ? h * 128 : 1024 + h * 128);
            const bf16_t* Kp = self ? Kb + (h >> 2) * 128 : KMb + (size_t)(h >> 1) * 65536 + (h & 1) * 128;
            const bf16_t* Vp = self ? Vb + (h >> 2) * 128 : VMb + (size_t)(h >> 1) * 65536 + (h & 1) * 128;
            bf16_t* Op = XCAT + (size_t)qb * 256 * 2048 + (self ? h * 128 : 1536 + h * 128);
            att::attn_dense_body<1536, 256, 2048>(Qp, Kp, Vp, Op, self ? S : MEMT, (char*)lds_raw, SSQ + (size_t)qb * 256 * 16 + (self ? h : 8 + h), tid);
        }
        if ((P3_MASK & 4) && bx >= G / 2) for (int w = bx - G / 2; w < 256; w += G - G / 2) {
            const int c = w >> 2, g = w & 3; LAS bf16_t* vt = (LAS bf16_t*)lds; constexpr int PITCH = 144;
            const int fr = lane & 15, fq = lane >> 4, i0 = wave * 16;
            {
                u32x4 vst[4];
#pragma unroll
                for (int q = 0; q < 4; ++q) { const int ch = tid + q * 512, jr = ch >> 4, dc = (ch & 15) * 8; vst[q] = *(const u32x4*)(GVb + (size_t)(c * 128 + jr) * 512 + g * 128 + dc); }
                const float* wsr = a.w_spatial + (size_t)g * 128 * 128 + (size_t)(i0 + fr) * 128 + fq * 8;
                f32x4 wv[4][2], sv[4][2];
#pragma unroll
                for (int ks = 0; ks < 4; ++ks) { wv[ks][0] = *(const f32x4*)(wsr + ks * 32); wv[ks][1] = *(const f32x4*)(wsr + ks * 32 + 4);
                    const float* sp = SSVP + ((size_t)c * 128 + ks * 32 + fq * 8) * 2; const f32x4 p0 = *(const f32x4*)sp, p1 = *(const f32x4*)(sp + 4), p2 = *(const f32x4*)(sp + 8), p3 = *(const f32x4*)(sp + 12);
                    sv[ks][0] = (f32x4){p0[0] + p0[1], p0[2] + p0[3], p1[0] + p1[1], p1[2] + p1[3]}; sv[ks][1] = (f32x4){p2[0] + p2[1], p2[2] + p2[3], p3[0] + p3[1], p3[2] + p3[3]}; }
                const size_t t = (size_t)c * 128 + i0 + fr;
                const float bs = a.b_spatial[g * 128 + i0 + fr];
                u32x2 ubv[8]; f32x4 sg[8];
#pragma unroll
                for (int n = 0; n < 8; ++n) { ubv[n] = *(const u32x2*)(Ub + t * 512 + g * 128 + n * 16 + fq * 4); sg[n] = *(const f32x4*)(a.sgu_norm + g * 128 + n * 16 + fq * 4); }
#pragma unroll
                for (int q = 0; q < 4; ++q) { const int ch = tid + q * 512, jr = ch >> 4, dc = (ch & 15) * 8; LAS bf16_t* p = vt + dc * PITCH + jr;
                    p[0 * PITCH] = (bf16_t)(vst[q].x & 0xffffu); p[1 * PITCH] = (bf16_t)(vst[q].x >> 16); p[2 * PITCH] = (bf16_t)(vst[q].y & 0xffffu); p[3 * PITCH] = (bf16_t)(vst[q].y >> 16);
                    p[4 * PITCH] = (bf16_t)(vst[q].z & 0xffffu); p[5 * PITCH] = (bf16_t)(vst[q].z >> 16); p[6 * PITCH] = (bf16_t)(vst[q].w & 0xffffu); p[7 * PITCH] = (bf16_t)(vst[q].w >> 16); }
                __syncthreads();
                f32x4 acc[8];
#pragma unroll
                for (int n = 0; n < 8; ++n) acc[n] = (f32x4){0.f, 0.f, 0.f, 0.f};
#pragma unroll
                for (int ks = 0; ks < 4; ++ks) {
                    f32x4 w0 = wv[ks][0], w1 = wv[ks][1];
#pragma unroll
                    for (int e = 0; e < 4; ++e) { w0[e] *= __builtin_amdgcn_rsqf(sv[ks][0][e] * (1.f / 512.f) + EPS); w1[e] *= __builtin_amdgcn_rsqf(sv[ks][1][e] * (1.f / 512.f) + EPS); }
                    const u32x4 aw = pg8::pack8(w0, w1); const bf16x8 wf = *reinterpret_cast<const bf16x8*>(&aw);
#pragma unroll
                    for (int n = 0; n < 8; ++n) { const bf16x8 vf = *(const LAS bf16x8*)(vt + (n * 16 + fr) * PITCH + ks * 32 + fq * 8);
                        acc[n] = __builtin_amdgcn_mfma_f32_16x16x32_bf16(vf, wf, acc[n], 0, 0, 0); }
                }
#pragma unroll
                for (int n = 0; n < 8; ++n) { f32x4 o;
                    o[0] = __uint_as_float(ubv[n].x << 16) * (acc[n][0] * sg[n][0] + bs); o[1] = __uint_as_float(ubv[n].x & 0xffff0000u) * (acc[n][1] * sg[n][1] + bs);
                    o[2] = __uint_as_float(ubv[n].y << 16) * (acc[n][2] * sg[n][2] + bs); o[3] = __uint_as_float(ubv[n].y & 0xffff0000u) * (acc[n][3] * sg[n][3] + bs);
                    *(u32x2*)(XCAT + t * 2048 + 1024 + g * 128 + n * 16 + fq * 4) = pg8::pack4(o); }
                __syncthreads();
            }
        }
    }
    SYNC(3);

    if (IN(4)) { PHASE_ENTER();
        pg8::Gemm g{XCAT, WcatT, DM}; pg8::BranchOrder So; So.init(S, DM, G, bx);
        pg8::EpiBranch E{};
        pg8::gemm_phase(lds, g, So, E, tid);
    }
    SYNC(4);

    if (IN(5)) { PHASE_ENTER();
        pg8::Gemm g{MERGED, WoutT, DM}; pg8::StaticOrder So; So.init(S, DM, DM, G, bx);
        pg8::EpiOut E{xch};
        pg8::gemm_phase(lds, g, So, E, tid, pg8::ResidInit{0});
    }
    SYNC(5);

    if (IN(6)) { PHASE_ENTER();
        pg8::Gemm g{A2, WupT, DM}; pg8::StaticOrder So; So.init(S, DFF, DM, G, bx);
        pg8::EpiUp E; { pg8::Unit u0; E.pm0 = So.next(0, u0) ? u0.pm : -1;
            const int wid_ = tid >> 6; pg8::EpiUp::load_rs((const float*)(ws + WS_SMALL + SM_ROWSSP), (E.pm0 < 0 ? 0 : E.pm0) * 256 + (wid_ >> 2) * 64 + (lane & 15), E.rs0); }
        pg8::gemm_phase(lds, g, So, E, tid);
    }
    SYNC(6);

    if (IN(7)) { PHASE_ENTER();
        pg8::Gemm g{U2, WdownT, DFF}; pg8::StaticOrder So; So.init(S, DM, DFF, G, bx);
        pg8::EpiDown E{};
        pg8::gemm_phase(lds, g, So, E, tid, pg8::ResidInit{1});
    }
#undef IN
#undef SYNC
#undef a
}

extern "C" void kernel_launch(void* const* d_in, const int* in_sizes, int n_in, void* d_out, int out_size, void* d_ws, size_t ws_size, hipStream_t stream) {
    static int grid = 0;
    if (grid == 0) {
        if (n_in != 20 || in_sizes[0] != S * DM || out_size != S * DM || ws_size < WS_END) {
            fprintf(stderr, "kernel_launch: unexpected shapes: n_in %d in0 %d out %d ws %zu (need %zu)\n", n_in, n_in > 0 ? in_sizes[0] : -1, out_size, ws_size, (size_t)WS_END); grid = -1; return; }
        int dev = 0, cus = 0, per_cu = 0;
        hipGetDevice(&dev); hipDeviceGetAttribute(&cus, hipDeviceAttributeMultiprocessorCount, dev);
        if (hipFuncSetAttribute((const void*)fwd_megakernel, hipFuncAttributeMaxDynamicSharedMemorySize, LDS_BYTES) != hipSuccess) { fprintf(stderr, "kernel_launch: hipFuncSetAttribute failed\n"); grid = -1; return; }
        if (hipOccupancyMaxActiveBlocksPerMultiprocessor(&per_cu, (const void*)fwd_megakernel, 512, LDS_BYTES) != hipSuccess || per_cu < 1) { fprintf(stderr, "kernel_launch: occupancy query failed (%d)\n", per_cu); grid = -1; return; }
        grid = cus;
        fprintf(stderr, "kernel_launch: cus %d per_cu %d grid %d\n", cus, per_cu, grid);
    }
    if (grid < 0) return;
    Args a{};
    const float** f = (const float**)&a;
    for (int i = 0; i < 20; ++i) f[i] = (const float*)d_in[i];
    a.out = (float*)d_out; a.ws = (unsigned char*)d_ws;
#ifndef PROBE_A
#define PROBE_A 8
#define PROBE_B 8
#endif
    hipError_t e = hipSuccess;
    for (int li = 0; li < (PROBE_A < 8 || PROBE_B < 8 ? 2 : 1); ++li) {
        a.ph_lo = li == 0 ? 0 : PROBE_B; a.ph_hi = li == 0 ? PROBE_A : 8;
        if (hipMemsetAsync((char*)d_ws + WS_SMALL + SM_BAR, 0, XCD_BAR_WORDS * 4, stream) != hipSuccess) { fprintf(stderr, "kernel_launch: memset failed\n"); return; }
        void* args[] = {&a};
        e = hipLaunchCooperativeKernel((const void*)fwd_megakernel, dim3(grid), dim3(512), args, LDS_BYTES, stream);
        if (e != hipSuccess) break;
    }
    if (e != hipSuccess) fprintf(stderr, "kernel_launch: cooperative launch failed: %s (grid %d)\n", hipGetErrorString(e), grid);
}
```

```cpp
#include <hip/hip_runtime.h>
#include <hip/hip_cooperative_groups.h>
#include <cstdio>
#include <cstdint>
namespace cg = cooperative_groups;

#define LAS __attribute__((address_space(3)))
typedef unsigned short bf16_t;
typedef short bf16x8 __attribute__((ext_vector_type(8)));
typedef short s16x4 __attribute__((ext_vector_type(4)));
typedef float f32x4 __attribute__((ext_vector_type(4)));
typedef float f32x8 __attribute__((ext_vector_type(8)));
typedef float f32x16 __attribute__((ext_vector_type(16)));
typedef unsigned u32x4 __attribute__((ext_vector_type(4)));
typedef unsigned u32x2 __attribute__((ext_vector_type(2)));

constexpr int S = 8192, DM = 2048, INW = 9216, DFF = 8192, MEMT = 256;
constexpr float EPS = 1e-6f;
constexpr size_t MiB = 1024ull * 1024ull;
constexpr size_t WS_WDOWN = 0 * MiB, WS_WUP = 32 * MiB, WS_WOUT = 64 * MiB, WS_WCAT = 72 * MiB, WS_H = 80 * MiB  ,
                 WS_SMALL = 112 * MiB, WS_R0 = 116 * MiB  , WS_WMKV = 152 * MiB, WS_GATES = 156 * MiB,
                 WS_QMRAW = 252 * MiB, WS_VB = 268 * MiB, WS_UB = 272 * MiB, WS_END = 280 * MiB;
constexpr size_t SM_ROWSS = 0, SM_SSV = 32 * 1024, SM_MEMN = 64 * 1024, SM_KMRAW = SM_MEMN + 1 * MiB, SM_KMB = SM_KMRAW + 512 * 1024, SM_VMB = SM_KMB + 256 * 1024, SM_BAR = 2560 * 1024  , SM_CS = SM_BAR + 64 * 1024  , SM_SSQ = 3072 * 1024  ,
                 SM_ROWSSP = 3584 * 1024  , SM_SSVP = 3840 * 1024  ;
constexpr size_t R0_QB = 0  , R0_KB = 24 * MiB, R0_VN = 28 * MiB;
constexpr int LDS_ST_OFF = 133120, LDS_XCH_OFF = 133136  , LDS_BYTES = 133136 + 8192;

struct Args {
    const float *x, *mem, *norm_mix, *w_in, *q_norm, *k_norm, *sgu_norm, *w_spatial, *b_spatial, *mem_norm, *w_mem_kv, *mq_norm, *mk_norm,
                *w_attn_o, *w_gmlp_o, *w_mem_o, *w_out, *norm_ffn, *w_ffn_up, *w_ffn_down;
    float* out; unsigned char* ws; int ph_lo, ph_hi;
};
typedef __attribute__((address_space(4))) const Args CArgs;
#define ARGP() ({ CArgs* p_ = (CArgs*)__builtin_amdgcn_kernarg_segment_ptr(); asm volatile("" : "+s"(p_)); p_; })

typedef __bf16 bf16x2_t __attribute__((ext_vector_type(2)));
typedef float f32x2_t __attribute__((ext_vector_type(2)));
__device__ __forceinline__ unsigned cvt_pk_bf16(float lo, float hi) { const f32x2_t f = {lo, hi}; const bf16x2_t b = __builtin_convertvector(f, bf16x2_t); return __builtin_bit_cast(unsigned, b); }
__device__ __forceinline__ float wave_sum(float v) {
#pragma unroll
    for (int o = 1; o < 64; o <<= 1) v += __shfl_xor(v, o);
    return v;
}
__device__ __forceinline__ float gelu_tanh(float x) {
    const float e = __builtin_amdgcn_exp2f(x * (-2.302208198f - 0.10294324f * x * x));
    return x * __builtin_amdgcn_rcpf(1.0f + e);
}
__device__ __forceinline__ float sigmoidf_(float z) { return __builtin_amdgcn_rcpf(1.0f + __builtin_amdgcn_exp2f(-1.4426950408889634f * z)); }

namespace pg8 {
constexpr int BM = 256, BK = 64, HALF = 128, HTB = HALF * BK * 2, STAGE_BYTES = 8 * HTB, NXCD = 8, WGM = 8;
__device__ __forceinline__ int lds_byte(int r, int c) { const int st = (r >> 4) * 2 + (c >> 5), rr = r & 15, cc = c & 31, ob = rr * 64 + cc * 2; return st * 1024 + (ob ^ (((ob >> 9) & 1) << 5)); }
__device__ __forceinline__ void stage_rc(int b, int& R, int& C) { const int st = b / 1024, sb = b % 1024, swz = sb ^ (((sb >> 9) & 1) << 5); R = (st >> 1) * 16 + swz / 64; C = (st & 1) * 32 + (swz % 64) / 2; }
__device__ __forceinline__ int perm32(int rho) { const int n = rho >> 4, i = rho & 15; return 8 * (i >> 2) + 4 * n + (i & 3); }

struct Unit { int pm, pn, kb, nt, tag, keep; };
struct Gemm { const bf16_t* A; const bf16_t* Bt; int K; };

__device__ __forceinline__ void map_tile(long L, int nM, int nN, int& pm, int& pn) {
    const int nwg = nM * nN; int wgid = (int)L;
    { const int q = nwg / NXCD, r = nwg % NXCD, xcd = wgid % NXCD, off = wgid / NXCD; wgid = (xcd < r ? xcd * (q + 1) : r * (q + 1) + (xcd - r) * q) + off; }
    const int nig = WGM * nN, gid = wgid / nig, fm = gid * WGM, gsz = (nM - fm) < WGM ? (nM - fm) : WGM;
    pm = fm + ((wgid % nig) % gsz); pn = (wgid % nig) / gsz;
}
struct StaticOrder {
    int nM, nN, nwg, G, c, nt;
    __device__ void init(int M, int N, int K, int G_, int c_) { nM = M / BM; nN = N / BM; nwg = nM * nN; G = G_; c = c_; nt = K / BK; }
    __device__ bool next(int i, Unit& u) const {
        const long L = (long)i * G + c; if (L >= nwg) return false;
        map_tile(L, nM, nN, u.pm, u.pn); u.kb = 0; u.nt = nt; u.tag = 0; u.keep = 0; return true;
    }
};
struct InProjOrder : StaticOrder {
    __device__ bool next(int i, Unit& u) const {
        if (!StaticOrder::next(i, u)) return false;
        const unsigned long long T0 = 0x34c0c11c608014bull, T1 = 0x5d65544d24503ceull, T2 = 0x75c6da288658244ull, T3 = 0x8e28607deull;
        const int k = u.pn / 10, j = u.pn - 10 * k; const unsigned long long t = k == 0 ? T0 : (k == 1 ? T1 : (k == 2 ? T2 : T3));
        u.pn = (int)((t >> (6 * j)) & 63ull); return true;
    }
};
struct BranchOrder {
    int nM, nN, nwg, G, c;
    __device__ void init(int M, int N, int G_, int c_) { nM = M / BM; nN = N / BM; nwg = nM * nN; G = G_; c = c_; }
    __device__ bool next(int i, Unit& u) const {
        const int ti = i / 3, br = i - 3 * ti; const long L = (long)ti * G + c; if (L >= nwg) return false;
        map_tile(L, nM, nN, u.pm, u.pn); u.kb = (br == 0 ? 0 : (br == 1 ? 1024 : 1536)) * 2; u.nt = (br == 0 ? 16 : 8); u.tag = br; u.keep = br < 2; return true;
    }
};

struct ZeroInit { __device__ __forceinline__ void operator()(f32x4 (&acc)[2][2][4][2], const Unit&, int, int, int, int) const {
#pragma unroll
    for (int a = 0; a < 2; ++a)
#pragma unroll
        for (int b = 0; b < 2; ++b)
#pragma unroll
            for (int m = 0; m < 4; ++m)
#pragma unroll
                for (int n = 0; n < 2; ++n) acc[a][b][m][n] = (f32x4){0.f, 0.f, 0.f, 0.f}; } };
template <class Epi, class Sched, class Init = ZeroInit>
__device__ __forceinline__ void gemm_phase(LAS unsigned char* lds, const Gemm g, const Sched& S, const Epi& E, const int tid, const Init& I = Init()) {
    const int wid = __builtin_amdgcn_readfirstlane(tid >> 6), lane = tid & 63, wr = wid >> 2, wc = wid & 3, fr = lane & 15, fq = lane >> 4;
    const int K = g.K;
    unsigned voffA[2], voffB[2];
#pragma unroll
    for (int i = 0; i < 2; ++i) { int R, C; stage_rc(tid * 16 + i * 8192, R, C); const int Rb = (R & ~31) + perm32(R & 31);
        voffA[i] = (unsigned)(R * K + C) * 2u; voffB[i] = (unsigned)(Rb * K + C) * 2u; }
    const size_t kstep = (size_t)(BK * 2);
    const size_t hstep = (size_t)HALF * K * 2;
    const size_t tstep = 2 * hstep;
    const unsigned ldsw = (unsigned)wid * 1024u;
    const int aoff = lds_byte(wr * 64 + fr, fq * 8), boff = lds_byte(wc * 32 + fr, fq * 8);
#define PG8_SA(b, h) (((b) * 2 + (h)) * HTB)
#define PG8_SB(b, h) ((4 + (b) * 2 + (h)) * HTB)
#define PG8_STAGE(bufoff, gbase, voff) do { _Pragma("unroll") for (int _i = 0; _i < 2; ++_i) \
        __builtin_amdgcn_global_load_lds((const unsigned*)((const char*)(gbase) + (voff)[_i]), (LAS unsigned*)(lds + (bufoff) + ldsw + _i * 8192), 16, 0, 0); } while (0)
#define PG8_LDA(dst, b, h) do { _Pragma("unroll") for (int m = 0; m < 4; ++m) _Pragma("unroll") for (int k = 0; k < 2; ++k) dst[m][k] = *(const LAS bf16x8*)(lds + PG8_SA(b, h) + aoff + m * 2048 + k * 1024); } while (0)
#define PG8_LDB(dst, b, h) do { _Pragma("unroll") for (int n = 0; n < 2; ++n) _Pragma("unroll") for (int k = 0; k < 2; ++k) dst[n][k] = *(const LAS bf16x8*)(lds + PG8_SB(b, h) + boff + n * 2048 + k * 1024); } while (0)
#define PG8_MMA(ai, bj, At, Bt) do { __builtin_amdgcn_s_setprio(1); _Pragma("unroll") for (int m = 0; m < 4; ++m) _Pragma("unroll") for (int n = 0; n < 2; ++n) _Pragma("unroll") for (int k = 0; k < 2; ++k) \
        acc[ai][bj][m][n] = __builtin_amdgcn_mfma_f32_16x16x32_bf16(Bt[n][k], At[m][k], acc[ai][bj][m][n], 0, 0, 0); __builtin_amdgcn_s_setprio(0); } while (0)
#define PG8_WAIT_V(n) asm volatile("s_waitcnt vmcnt(" #n ")" ::: "memory")
#define PG8_WAIT_L(n) asm volatile("s_waitcnt lgkmcnt(" #n ")" ::: "memory")
#define PG8_BAR __builtin_amdgcn_s_barrier()
#define PG8_SCHED __builtin_amdgcn_sched_barrier(0)
    Unit cur, nxt; int ui = 0;
    if (!S.next(0, cur)) return;
    f32x4 acc[2][2][4][2];
    I(acc, cur, wr, wc, fr, fq);
    bf16x8 At[4][2], B0[2][2], B1[2][2];
    const char* cA = (const char*)g.A + (size_t)cur.pm * tstep + cur.kb; const char* cB = (const char*)g.Bt + (size_t)cur.pn * tstep + cur.kb;
    PG8_STAGE(PG8_SB(0, 0), cB, voffB); PG8_STAGE(PG8_SA(0, 0), cA, voffA); PG8_STAGE(PG8_SB(0, 1), cB + hstep, voffB); PG8_STAGE(PG8_SA(0, 1), cA + hstep, voffA);
    if (wr == 1) PG8_BAR;
    PG8_WAIT_V(4); PG8_BAR;
    PG8_STAGE(PG8_SB(1, 0), cB + kstep, voffB); PG8_STAGE(PG8_SA(1, 0), cA + kstep, voffA); PG8_STAGE(PG8_SB(1, 1), cB + hstep + kstep, voffB);
    PG8_WAIT_V(6); PG8_BAR;
    for (;;) {
        const bool has_next = S.next(ui + 1, nxt);
        const char* nA = has_next ? (const char*)g.A + (size_t)nxt.pm * tstep + nxt.kb : cA; const char* nB = has_next ? (const char*)g.Bt + (size_t)nxt.pn * tstep + nxt.kb : cB;
        const int nt = cur.nt;
        for (int t = 0; t < nt; t += 2) {
            const bool last = (t == nt - 2);
            const char* a1 = cA + (size_t)(t + 1) * kstep;
            const char* a2 = last ? nA : cA + (size_t)(t + 2) * kstep; const char* b2 = last ? nB : cB + (size_t)(t + 2) * kstep;
            const char* a3 = a2 + kstep; const char* b3 = b2 + kstep;
            PG8_LDB(B0, 0, 0); PG8_SCHED; PG8_LDA(At, 0, 0); PG8_STAGE(PG8_SA(1, 1), a1 + hstep, voffA);
            PG8_WAIT_L(8); PG8_BAR; PG8_WAIT_L(0); PG8_MMA(0, 0, At, B0); PG8_BAR; PG8_SCHED;
            PG8_LDB(B1, 0, 1); PG8_STAGE(PG8_SB(0, 0), b2, voffB);
            PG8_BAR; PG8_WAIT_L(0); PG8_MMA(0, 1, At, B1); PG8_BAR;
            PG8_LDA(At, 0, 1); PG8_STAGE(PG8_SA(0, 0), a2, voffA);
            PG8_BAR; PG8_WAIT_L(0); PG8_MMA(1, 0, At, B0); PG8_BAR; PG8_SCHED;
            PG8_STAGE(PG8_SB(0, 1), b2 + hstep, voffB);
            PG8_WAIT_V(6); PG8_BAR; PG8_MMA(1, 1, At, B1); PG8_BAR;
            PG8_LDB(B0, 1, 0); PG8_SCHED; PG8_LDA(At, 1, 0); PG8_STAGE(PG8_SA(0, 1), a2 + hstep, voffA);
            PG8_WAIT_L(8); PG8_BAR; PG8_WAIT_L(0); PG8_MMA(0, 0, At, B0); PG8_BAR; PG8_SCHED;
            PG8_LDB(B1, 1, 1); PG8_STAGE(PG8_SB(1, 0), b3, voffB);
            PG8_BAR; PG8_WAIT_L(0); PG8_MMA(0, 1, At, B1); PG8_BAR;
            PG8_LDA(At, 1, 1); PG8_STAGE(PG8_SA(1, 0), a3, voffA);
            PG8_BAR; PG8_WAIT_L(0); PG8_MMA(1, 0, At, B0); PG8_BAR; PG8_SCHED;
            PG8_STAGE(PG8_SB(1, 1), b3 + hstep, voffB);
            PG8_WAIT_V(6); PG8_BAR; PG8_MMA(1, 1, At, B1); PG8_BAR;
        }
        E(acc, cur, wr, wc, fr, fq);
        if (!has_next) break;
        if (!cur.keep) I(acc, nxt, wr, wc, fr, fq);
        cur = nxt; cA = nA; cB = nB; ++ui;
    }
    PG8_WAIT_V(0);
    if (wr == 0) PG8_BAR;
    PG8_BAR;
#undef PG8_SA
#undef PG8_SB
#undef PG8_STAGE
#undef PG8_LDA
#undef PG8_LDB
#undef PG8_MMA
#undef PG8_WAIT_V
#undef PG8_WAIT_L
#undef PG8_BAR
#undef PG8_SCHED
}

__device__ __forceinline__ u32x4 pack8(f32x4 v0, f32x4 v1) { u32x4 w; w.x = cvt_pk_bf16(v0[0], v0[1]); w.y = cvt_pk_bf16(v0[2], v0[3]); w.z = cvt_pk_bf16(v1[0], v1[1]); w.w = cvt_pk_bf16(v1[2], v1[3]); return w; }

__device__ __forceinline__ u32x2 pack4(f32x4 v) { u32x2 w; w.x = cvt_pk_bf16(v[0], v[1]); w.y = cvt_pk_bf16(v[2], v[3]); return w; }
__device__ __forceinline__ float sumsq8(f32x4 a, f32x4 b) { return (a[0] * a[0] + a[1] * a[1]) + (a[2] * a[2] + a[3] * a[3]) + (b[0] * b[0] + b[1] * b[1]) + (b[2] * b[2] + b[3] * b[3]); }
template <bool GELU = false>
__device__ __forceinline__ void head_ss_exchange(const f32x4 (&acc)[2][2][4][2], LAS float* xch, int wr, int wc, int fr, int fq, float (&tot)[2][4][2]) {
#pragma unroll
    for (int ai = 0; ai < 2; ++ai)
#pragma unroll
        for (int m = 0; m < 4; ++m)
#pragma unroll
            for (int bj = 0; bj < 2; ++bj) { f32x4 a0 = acc[ai][bj][m][0], a1 = acc[ai][bj][m][1];
                if (GELU) {
#pragma unroll
                    for (int j = 0; j < 4; ++j) { a0[j] = gelu_tanh(a0[j]); a1[j] = gelu_tanh(a1[j]); } }
                float ss = sumsq8(a0, a1); ss += __shfl_xor(ss, 16); ss += __shfl_xor(ss, 32);
                if (fq == 0) xch[((wr * 128 + (ai * 4 + m) * 16 + fr) * 2 + bj) * 4 + wc] = ss; }
    asm volatile("s_waitcnt lgkmcnt(0)" ::: "memory"); __builtin_amdgcn_s_barrier(); asm volatile("" ::: "memory");
#pragma unroll
    for (int ai = 0; ai < 2; ++ai)
#pragma unroll
        for (int m = 0; m < 4; ++m)
#pragma unroll
            for (int bj = 0; bj < 2; ++bj) { const f32x4 p = *(const LAS f32x4*)(xch + ((wr * 128 + (ai * 4 + m) * 16 + fr) * 2 + bj) * 4); tot[ai][m][bj] = (p[0] + p[1]) + (p[2] + p[3]); }
}
struct EpiInProj {
    LAS float* xch;
    __device__ __forceinline__ void operator()(const f32x4 (&acc)[2][2][4][2], const Unit& u, int wr, int wc, int fr, int fq) const {
        CArgs* ap = ARGP(); unsigned char* ws = ap->ws; unsigned char* ob = (unsigned char*)ap->out;
        bf16_t* QALL = (bf16_t*)(ob + R0_QB); bf16_t* Kb = (bf16_t*)(ob + R0_KB); bf16_t* GVb = (bf16_t*)(ob + R0_VN);
        bf16_t* Vb = (bf16_t*)(ws + WS_VB); bf16_t* Ub = (bf16_t*)(ws + WS_UB); bf16_t* GATES = (bf16_t*)(ws + WS_GATES);
        float* SSVP = (float*)(ws + WS_SMALL + SM_SSVP); const float* CS = (const float*)(ws + WS_SMALL + SM_CS);
        const float* q_norm = ap->q_norm; const float* k_norm = ap->k_norm; const float* mq_norm = ap->mq_norm;
        const int pn = u.pn; const int row0 = u.pm * BM + wr * 64 + fr, cl = wc * 32 + 8 * fq;
        if (pn < 5) {
            const bool isk = (pn == 4);
            float tot[2][4][2];
            head_ss_exchange(acc, xch, wr, wc, fr, fq, tot);
            const int hf = wc >> 1, f0 = 16 * (wc & 1) + 4 * fq, dh = 64 * hf + f0;
            const float* gn = isk ? k_norm : q_norm;
            const f32x4 g0 = *(const f32x4*)(gn + dh), g1 = *(const f32x4*)(gn + dh + 32);
#pragma unroll
            for (int ai = 0; ai < 2; ++ai) {
                f32x4 csv[4][2];
#pragma unroll
                for (int m = 0; m < 4; ++m) { const int t = row0 + ai * HALF + m * 16; const int pos = hf ? (t & 63) : (t >> 6);
                    const float* csp = CS + (size_t)(pos * 32 + f0) * 2; csv[m][0] = *(const f32x4*)csp; csv[m][1] = *(const f32x4*)(csp + 4); }
#pragma unroll
                for (int m = 0; m < 4; ++m) { const int t = row0 + ai * HALF + m * 16;
                    const f32x4 cs0 = csv[m][0], cs1 = csv[m][1];
                    const f32x4 cc = {cs0[0], cs0[2], cs1[0], cs1[2]}, sn = {cs0[1], cs0[3], cs1[1], cs1[3]};
#pragma unroll
                    for (int bj = 0; bj < 2; ++bj) { f32x4 v0 = acc[ai][bj][m][0], v1 = acc[ai][bj][m][1];
                        { const float r = __builtin_amdgcn_rsqf(tot[ai][m][bj] * (1.f / 128.f) + EPS); v0 *= r; v1 *= r; }
                        const f32x4 y0 = v0 * g0, y1 = v1 * g1;
                        const f32x4 o0 = y0 * cc - y1 * sn, o1 = y1 * cc + y0 * sn;
                        bf16_t* dst = isk ? Kb + (size_t)t * 256 + bj * 128 + dh : QALL + (size_t)t * 1536 + (pn * 2 + bj) * 128 + dh;
                        *(u32x2*)dst = pack4(o0); *(u32x2*)(dst + 32) = pack4(o1); } }
            }
            return;
        }
        if (pn >= 8 && pn < 12) {
            const bool isqm = pn >= 10;
            f32x4 g0 = {1.f, 1.f, 1.f, 1.f}, g1 = g0;
            if (isqm) { g0 = *(const f32x4*)(mq_norm + cl); g1 = *(const f32x4*)(mq_norm + cl + 4); }
            float tot[2][4][2];
            if (isqm) head_ss_exchange<false>(acc, xch, wr, wc, fr, fq, tot); else head_ss_exchange<true>(acc, xch, wr, wc, fr, fq, tot);
#pragma unroll
            for (int ai = 0; ai < 2; ++ai)
#pragma unroll
                for (int m = 0; m < 4; ++m) { const int t = row0 + ai * HALF + m * 16;
#pragma unroll
                    for (int bj = 0; bj < 2; ++bj) { f32x4 v0 = acc[ai][bj][m][0], v1 = acc[ai][bj][m][1];
                        if (isqm) { const float r = __builtin_amdgcn_rsqf(tot[ai][m][bj] * (1.f / 128.f) + EPS);
                            *(u32x4*)(QALL + (size_t)t * 1536 + 1024 + (pn - 10) * 256 + bj * HALF + cl) = pack8(v0 * r * g0, v1 * r * g1); }
                        else {
#pragma unroll
                            for (int j = 0; j < 4; ++j) { v0[j] = gelu_tanh(v0[j]); v1[j] = gelu_tanh(v1[j]); }
                            *(u32x4*)(GVb + (size_t)t * 512 + (pn - 8) * 256 + bj * HALF + cl) = pack8(v0, v1); } }
                    if (!isqm && wc == 0 && fq == 0) SSVP[(size_t)t * 2 + (pn - 8)] = tot[ai][m][0] + tot[ai][m][1]; }
            return;
        }
        int mode, ld, c0; bf16_t* base;
        if (pn == 5)      { base = Vb;    ld = 256;  c0 = 0; mode = 0; }
        else if (pn < 8)  { base = Ub;    ld = 512;  c0 = (pn - 6) * 256; mode = 1; }
        else              { base = GATES; ld = 6144; c0 = (pn - 12) * 256; mode = 2; }
#pragma unroll
        for (int ai = 0; ai < 2; ++ai)
#pragma unroll
            for (int m = 0; m < 4; ++m) { const size_t roff = (size_t)(row0 + ai * HALF + m * 16) * ld + c0 + cl;
#pragma unroll
                for (int bj = 0; bj < 2; ++bj) { f32x4 v0 = acc[ai][bj][m][0], v1 = acc[ai][bj][m][1];
                    if (mode == 1) {
#pragma unroll
                        for (int j = 0; j < 4; ++j) { v0[j] = gelu_tanh(v0[j]); v1[j] = gelu_tanh(v1[j]); } }
                    else if (mode == 2) {
#pragma unroll
                        for (int j = 0; j < 4; ++j) { v0[j] = sigmoidf_(v0[j]); v1[j] = sigmoidf_(v1[j]); } }
                    *(u32x4*)(base + roff + bj * HALF) = pack8(v0, v1); } }
    }
};
struct EpiMemKV {
    LAS float* xch;
    __device__ __forceinline__ void operator()(const f32x4 (&acc)[2][2][4][2], const Unit& u, int wr, int wc, int fr, int fq) const {
        CArgs* ap = ARGP(); unsigned char* ws = ap->ws; bf16_t* KMb = (bf16_t*)(ws + WS_SMALL + SM_KMB); bf16_t* VMb = (bf16_t*)(ws + WS_SMALL + SM_VMB); const float* mk_norm = ap->mk_norm;
        const int pn = u.pn; const int row0 = u.pm * BM + wr * 64 + fr, cl = wc * 32 + 8 * fq;
        float tot[2][4][2];
        if (pn < 2) head_ss_exchange(acc, xch, wr, wc, fr, fq, tot);
        const f32x4 g0 = *(const f32x4*)(mk_norm + cl), g1 = *(const f32x4*)(mk_norm + cl + 4);
#pragma unroll
        for (int ai = 0; ai < 2; ++ai)
#pragma unroll
            for (int m = 0; m < 4; ++m) { const size_t roff = (size_t)(pn & 1) * 65536 + (size_t)(row0 + ai * HALF + m * 16) * 256 + cl;
#pragma unroll
                for (int bj = 0; bj < 2; ++bj) { f32x4 v0 = acc[ai][bj][m][0], v1 = acc[ai][bj][m][1];
                    if (pn < 2) { const float r = __builtin_amdgcn_rsqf(tot[ai][m][bj] * (1.f / 128.f) + EPS); v0 = v0 * r * g0; v1 = v1 * r * g1; *(u32x4*)(KMb + roff + bj * HALF) = pack8(v0, v1); }
                    else { *(u32x4*)(VMb + roff + bj * HALF) = pack8(v0, v1); } } }
    }
};
__device__ __forceinline__ void unpack8(const u32x4 w, f32x4& lo, f32x4& hi) {
    lo[0] = __uint_as_float(w.x << 16); lo[1] = __uint_as_float(w.x & 0xffff0000u); lo[2] = __uint_as_float(w.y << 16); lo[3] = __uint_as_float(w.y & 0xffff0000u);
    hi[0] = __uint_as_float(w.z << 16); hi[1] = __uint_as_float(w.z & 0xffff0000u); hi[2] = __uint_as_float(w.w << 16); hi[3] = __uint_as_float(w.w & 0xffff0000u);
}
struct EpiBranch {
    __device__ __forceinline__ void operator()(f32x4 (&acc)[2][2][4][2], const Unit& u, int wr, int wc, int fr, int fq) const {
        unsigned char* ws = ARGP()->ws; const bf16_t* GATES = (const bf16_t*)(ws + WS_GATES); bf16_t* MERGED = (bf16_t*)(ws + WS_R0);
        const int br = u.tag; const int row0 = u.pm * BM + wr * 64 + fr, col0 = u.pn * BM + wc * 32 + 8 * fq;
        const bf16_t* gp = GATES + (size_t)row0 * 6144 + br * 2048 + col0;
#pragma unroll
        for (int ai = 0; ai < 2; ++ai) {
            u32x4 ga[4][2], gb[4][2];
#pragma unroll
            for (int m = 0; m < 4; ++m)
#pragma unroll
                for (int bj = 0; bj < 2; ++bj) { const bf16_t* p = gp + (size_t)(ai * HALF + m * 16) * 6144 + bj * HALF;
                    ga[m][bj] = *(const u32x4*)p; if (br < 2) gb[m][bj] = *(const u32x4*)(p + 2048); }
#pragma unroll
            for (int m = 0; m < 4; ++m)
#pragma unroll
                for (int bj = 0; bj < 2; ++bj) { f32x4 g0, g1; unpack8(ga[m][bj], g0, g1);
                    if (br < 2) { f32x4 h0, h1; unpack8(gb[m][bj], h0, h1);
#pragma unroll
                        for (int j = 0; j < 4; ++j) { g0[j] *= __builtin_amdgcn_rcpf(h0[j]); g1[j] *= __builtin_amdgcn_rcpf(h1[j]); }
                        acc[ai][bj][m][0] *= g0; acc[ai][bj][m][1] *= g1; }
                    else { *(u32x4*)(MERGED + (size_t)(row0 + ai * HALF + m * 16) * DM + col0 + bj * HALF) = pack8(acc[ai][bj][m][0] * g0, acc[ai][bj][m][1] * g1); } }
        }
    }
};
struct ResidInit {
    int which;
    __device__ __forceinline__ void operator()(f32x4 (&acc)[2][2][4][2], const Unit& u, int wr, int wc, int fr, int fq) const {
        CArgs* ap = ARGP(); const float* R = which ? (const float*)ap->out : ap->x;
        const int row0 = u.pm * BM + wr * 64 + fr, col0 = u.pn * BM + wc * 32 + 8 * fq;
#pragma unroll
        for (int ai = 0; ai < 2; ++ai)
#pragma unroll
            for (int m = 0; m < 4; ++m)
#pragma unroll
                for (int bj = 0; bj < 2; ++bj) { const float* p = R + (size_t)(row0 + ai * HALF + m * 16) * DM + col0 + bj * HALF; acc[ai][bj][m][0] = *(const f32x4*)p; acc[ai][bj][m][1] = *(const f32x4*)(p + 4); }
    }
};
struct EpiOut {
    LAS float* xch;
    __device__ __forceinline__ void operator()(const f32x4 (&acc)[2][2][4][2], const Unit& u, int wr, int wc, int fr, int fq) const {
        CArgs* ap = ARGP(); unsigned char* ws = ap->ws; const float* G = ap->norm_ffn; float* X1 = ap->out; bf16_t* A2 = (bf16_t*)(ws + WS_H); float* ROWSSP = (float*)(ws + WS_SMALL + SM_ROWSSP);
        float tot[2][4][2];
        head_ss_exchange(acc, xch, wr, wc, fr, fq, tot);
        const int row0 = u.pm * BM + wr * 64 + fr, col0 = u.pn * BM + wc * 32 + 8 * fq;
        f32x4 g[2][2];
#pragma unroll
        for (int bj = 0; bj < 2; ++bj) { g[bj][0] = *(const f32x4*)(G + col0 + bj * HALF); g[bj][1] = *(const f32x4*)(G + col0 + bj * HALF + 4); }
#pragma unroll
        for (int ai = 0; ai < 2; ++ai)
#pragma unroll
            for (int m = 0; m < 4; ++m) { const int row = row0 + ai * HALF + m * 16;
#pragma unroll
                for (int bj = 0; bj < 2; ++bj) { const size_t off = (size_t)row * DM + col0 + bj * HALF;
                    const f32x4 v0 = acc[ai][bj][m][0], v1 = acc[ai][bj][m][1];
                    *(f32x4*)(X1 + off) = v0; *(f32x4*)(X1 + off + 4) = v1;
                    *(u32x4*)(A2 + off) = pack8(v0 * g[bj][0], v1 * g[bj][1]); }
                if (wc == 0 && fq == 0) ROWSSP[(size_t)row * 8 + u.pn] = tot[ai][m][0] + tot[ai][m][1]; }
    }
};
struct EpiUp {
    int pm0; float rs0[2][4];
    __device__ static __forceinline__ void load_rs(const float* ROWSSP, int row0, float (&rs)[2][4]) {
        float rsv[2][4];
#pragma unroll
        for (int ai = 0; ai < 2; ++ai)
#pragma unroll
            for (int m = 0; m < 4; ++m) { const float* pp = ROWSSP + (size_t)(row0 + ai * HALF + m * 16) * 8; const f32x4 pa = *(const f32x4*)pp, pb = *(const f32x4*)(pp + 4);
                rsv[ai][m] = ((pa[0] + pa[1]) + (pa[2] + pa[3])) + ((pb[0] + pb[1]) + (pb[2] + pb[3])); }
#pragma unroll
        for (int ai = 0; ai < 2; ++ai)
#pragma unroll
            for (int m = 0; m < 4; ++m) rs[ai][m] = __builtin_amdgcn_rsqf(rsv[ai][m] * (1.0f / DM) + EPS);
    }
    __device__ __forceinline__ void operator()(const f32x4 (&acc)[2][2][4][2], const Unit& u, int wr, int wc, int fr, int fq) const {
        unsigned char* ws = ARGP()->ws; const float* ROWSSP = (const float*)(ws + WS_SMALL + SM_ROWSSP); bf16_t* U2 = (bf16_t*)(ws + WS_R0);
        const int row0 = u.pm * BM + wr * 64 + fr, col0 = u.pn * BM + wc * 32 + 8 * fq;
        float rs[2][4];
        if (u.pm == pm0) {
#pragma unroll
            for (int ai = 0; ai < 2; ++ai)
#pragma unroll
                for (int m = 0; m < 4; ++m) rs[ai][m] = rs0[ai][m];
        } else load_rs(ROWSSP, row0, rs);
#pragma unroll
        for (int ai = 0; ai < 2; ++ai)
#pragma unroll
            for (int m = 0; m < 4; ++m) { const int row = row0 + ai * HALF + m * 16;
#pragma unroll
                for (int bj = 0; bj < 2; ++bj) { f32x4 v0 = acc[ai][bj][m][0] * rs[ai][m], v1 = acc[ai][bj][m][1] * rs[ai][m];
#pragma unroll
                    for (int j = 0; j < 4; ++j) { const float a = fmaxf(v0[j], 0.f), b = fmaxf(v1[j], 0.f); v0[j] = a * a; v1[j] = b * b; }
                    *(u32x4*)(U2 + (size_t)row * DFF + col0 + bj * HALF) = pack8(v0, v1); } }
    }
};
struct EpiDown {
    __device__ __forceinline__ void operator()(const f32x4 (&acc)[2][2][4][2], const Unit& u, int wr, int wc, int fr, int fq) const {
        float* OUT = ARGP()->out;
        const int row0 = u.pm * BM + wr * 64 + fr, col0 = u.pn * BM + wc * 32 + 8 * fq;
#pragma unroll
        for (int ai = 0; ai < 2; ++ai)
#pragma unroll
            for (int m = 0; m < 4; ++m)
#pragma unroll
                for (int bj = 0; bj < 2; ++bj) { float* p = OUT + (size_t)(row0 + ai * HALF + m * 16) * DM + col0 + bj * HALF; *(f32x4*)p = acc[ai][bj][m][0]; *(f32x4*)(p + 4) = acc[ai][bj][m][1]; }
    }
};
}

namespace att {
constexpr int D = 128, NW = 8, QBLK = 32, KVBLK = 64;
constexpr float SCALE = 0.088388347648318440f;
constexpr float THR = 8.f;
constexpr size_t SHM_V = KVBLK * D * 2, SHM_K = KVBLK * D * 2, SHM_ATTN = 2 * SHM_V + 2 * SHM_K + NW * 64 * 4;
#define KSWZ(row, colB) ((row) * 256 + ((colB) ^ (((row) & 7) << 4)))
#define SBAR() __builtin_amdgcn_sched_barrier(0)
__device__ __forceinline__ int crow(int r, int hi) { return (r & 3) + 8 * (r >> 2) + 4 * hi; }
__device__ __forceinline__ void partialSM(f32x16& p0, f32x16& p1, float& m_reg, float& mn, float& alpha) {
  constexpr float C = SCALE * 1.4426950408889634f;
  float pmax = p0[0];
#pragma unroll
  for (int r = 1; r < 16; ++r) pmax = fmaxf(pmax, p0[r]);
#pragma unroll
  for (int r = 0; r < 16; ++r) pmax = fmaxf(pmax, p1[r]);
  { auto rr = __builtin_amdgcn_permlane32_swap(__float_as_uint(pmax), __float_as_uint(pmax), false, false);
    pmax = fmaxf(__uint_as_float(rr[0]), __uint_as_float(rr[1])); }
  if (__builtin_expect(__all(pmax - m_reg <= THR / SCALE), 1)) { mn = m_reg; alpha = 1.f; }
  else { mn = fmaxf(m_reg, pmax); alpha = __builtin_amdgcn_exp2f((m_reg - mn) * C); m_reg = mn; }
  float mnC = -mn * C;
#pragma unroll
  for (int r = 0; r < 16; ++r) p0[r] = fmaf(p0[r], C, mnC);
#pragma unroll
  for (int r = 0; r < 16; ++r) p1[r] = fmaf(p1[r], C, mnC);
#pragma unroll
  for (int r = 0; r < 16; ++r) p0[r] = __builtin_amdgcn_exp2f(p0[r]);
}
__device__ __forceinline__ void finishSM(f32x16& p0, f32x16& p1, float alpha, float& l_reg, bf16x8& pa0, bf16x8& pa1, bf16x8& pa2, bf16x8& pa3) {
#pragma unroll
  for (int r = 0; r < 16; ++r) p1[r] = __builtin_amdgcn_exp2f(p1[r]);
  float ps = 0;
#pragma unroll
  for (int r = 0; r < 16; ++r) ps += p0[r];
#pragma unroll
  for (int r = 0; r < 16; ++r) ps += p1[r];
  { auto rr = __builtin_amdgcn_permlane32_swap(__float_as_uint(ps), __float_as_uint(ps), false, false);
    ps = __uint_as_float(rr[0]) + __uint_as_float(rr[1]); }
  l_reg = l_reg * alpha + ps;
#define PK4(P, BASE, OUT) do { unsigned a0 = cvt_pk_bf16(P[BASE + 0], P[BASE + 1]), a1 = cvt_pk_bf16(P[BASE + 2], P[BASE + 3]);   \
    unsigned b0 = cvt_pk_bf16(P[BASE + 4], P[BASE + 5]), b1 = cvt_pk_bf16(P[BASE + 6], P[BASE + 7]);                              \
    auto r0 = __builtin_amdgcn_permlane32_swap(a0, b0, false, false); auto r1 = __builtin_amdgcn_permlane32_swap(a1, b1, false, false); \
    u32x4 w = {r0[0], r1[0], r0[1], r1[1]}; OUT = *reinterpret_cast<bf16x8*>(&w); } while (0)
  PK4(p0, 0, pa0); PK4(p0, 8, pa1); PK4(p1, 0, pa2); PK4(p1, 8, pa3);
#undef PK4
}
__device__ __forceinline__ void qkt(f32x16& p0, f32x16& p1, const bf16_t* Ks, const bf16x8* qr, int r32, int hi) {
  p0 = f32x16{}; p1 = f32x16{};
#pragma unroll
  for (int d0 = 0; d0 < 8; ++d0) { int cb = (d0 * 16 + hi * 8) * 2;
    bf16x8 b0 = *reinterpret_cast<const bf16x8*>((const char*)Ks + KSWZ(r32, cb));
    bf16x8 b1 = *reinterpret_cast<const bf16x8*>((const char*)Ks + KSWZ(32 + r32, cb));
    p0 = __builtin_amdgcn_mfma_f32_32x32x16_bf16(b0, qr[d0], p0, 0, 0, 0);
    p1 = __builtin_amdgcn_mfma_f32_32x32x16_bf16(b1, qr[d0], p1, 0, 0, 0); }
}
__device__ __forceinline__ int v_st(int k, int c) { const int kk = (k & ~0xC) | ((k & 4) << 1) | ((k & 8) >> 1); return ((kk >> 3) * 4 + (c >> 5)) * 512 + ((kk & 7) * 32 + (c & 31)) * 2; }
__device__ __forceinline__ int v_rd_base(int lane) { return ((lane & 3) << 3) | (((lane >> 2) & 3) << 6) | (((lane >> 4) & 1) << 5) | (((lane >> 5) & 1) << 8); }
constexpr int v_rd_off(int d0, int ks, int half) { return d0 * 512 + ks * 4096 + half * 2048; }
template <int OFF> __device__ __forceinline__ s16x4 tr_read(int vb) {
  s16x4 r; asm volatile("ds_read_b64_tr_b16 %0, %1 offset:%2" : "=&v"(r) : "v"(vb), "i"(OFF) : "memory"); return r;
}
template <int D0> __device__ __forceinline__ void pv_one(f32x16& od, int vb, bf16x8 pa0, bf16x8 pa1, bf16x8 pa2, bf16x8 pa3) {
  const s16x4 l0 = tr_read<v_rd_off(D0, 0, 0)>(vb), h0 = tr_read<v_rd_off(D0, 0, 1)>(vb), l1 = tr_read<v_rd_off(D0, 1, 0)>(vb), h1 = tr_read<v_rd_off(D0, 1, 1)>(vb);
  const s16x4 l2 = tr_read<v_rd_off(D0, 2, 0)>(vb), h2 = tr_read<v_rd_off(D0, 2, 1)>(vb), l3 = tr_read<v_rd_off(D0, 3, 0)>(vb), h3 = tr_read<v_rd_off(D0, 3, 1)>(vb);
  asm volatile("s_waitcnt lgkmcnt(0)" ::: "memory"); SBAR();
#define PK(L, H) (bf16x8){L[0], L[1], L[2], L[3], H[0], H[1], H[2], H[3]}
  od = __builtin_amdgcn_mfma_f32_32x32x16_bf16(pa0, PK(l0, h0), od, 0, 0, 0);
  od = __builtin_amdgcn_mfma_f32_32x32x16_bf16(pa1, PK(l1, h1), od, 0, 0, 0);
  od = __builtin_amdgcn_mfma_f32_32x32x16_bf16(pa2, PK(l2, h2), od, 0, 0, 0);
  od = __builtin_amdgcn_mfma_f32_32x32x16_bf16(pa3, PK(l3, h3), od, 0, 0, 0);
#undef PK
}
#define PV_BLOCK_READS(D0) \
  const s16x4 l0_##D0 = tr_read<v_rd_off(D0, 0, 0)>(vb), h0_##D0 = tr_read<v_rd_off(D0, 0, 1)>(vb), l1_##D0 = tr_read<v_rd_off(D0, 1, 0)>(vb), h1_##D0 = tr_read<v_rd_off(D0, 1, 1)>(vb); \
  const s16x4 l2_##D0 = tr_read<v_rd_off(D0, 2, 0)>(vb), h2_##D0 = tr_read<v_rd_off(D0, 2, 1)>(vb), l3_##D0 = tr_read<v_rd_off(D0, 3, 0)>(vb), h3_##D0 = tr_read<v_rd_off(D0, 3, 1)>(vb);
#define PKV(L, H) (bf16x8){L[0], L[1], L[2], L[3], H[0], H[1], H[2], H[3]}
#define PV_BLOCK_MMA(D0) \
  asm volatile("s_waitcnt lgkmcnt(0)" ::: "memory"); SBAR(); \
  o[D0] = __builtin_amdgcn_mfma_f32_32x32x16_bf16(pa0, PKV(l0_##D0, h0_##D0), o[D0], 0, 0, 0); \
  o[D0] = __builtin_amdgcn_mfma_f32_32x32x16_bf16(pa1, PKV(l1_##D0, h1_##D0), o[D0], 0, 0, 0); \
  o[D0] = __builtin_amdgcn_mfma_f32_32x32x16_bf16(pa2, PKV(l2_##D0, h2_##D0), o[D0], 0, 0, 0); \
  o[D0] = __builtin_amdgcn_mfma_f32_32x32x16_bf16(pa3, PKV(l3_##D0, h3_##D0), o[D0], 0, 0, 0);
#define SGB4(NV) do { __builtin_amdgcn_sched_group_barrier(0x008, 1, 0); __builtin_amdgcn_sched_group_barrier(0x002, NV, 0); __builtin_amdgcn_sched_group_barrier(0x008, 1, 0); __builtin_amdgcn_sched_group_barrier(0x002, NV, 0); \
    __builtin_amdgcn_sched_group_barrier(0x008, 1, 0); __builtin_amdgcn_sched_group_barrier(0x002, NV, 0); __builtin_amdgcn_sched_group_barrier(0x008, 1, 0); __builtin_amdgcn_sched_group_barrier(0x002, NV, 0); } while (0)
__device__ __forceinline__ void pv_sm(f32x16* o, int vb, bf16x8 pa0, bf16x8 pa1, bf16x8 pa2, bf16x8 pa3, f32x16& p0, f32x16& p1, float& m_reg, float& mn, float& alpha) {
  constexpr float C = SCALE * 1.4426950408889634f;
  { PV_BLOCK_READS(0)
    PV_BLOCK_MMA(0)
    float pmax = p0[0];
#pragma unroll
    for (int r = 1; r < 16; ++r) pmax = fmaxf(pmax, p0[r]);
    mn = pmax;
    SGB4(2); }
  { PV_BLOCK_READS(1)
    PV_BLOCK_MMA(1)
    float pmax = mn;
#pragma unroll
    for (int r = 0; r < 16; ++r) pmax = fmaxf(pmax, p1[r]);
    { auto rr = __builtin_amdgcn_permlane32_swap(__float_as_uint(pmax), __float_as_uint(pmax), false, false);
      pmax = fmaxf(__uint_as_float(rr[0]), __uint_as_float(rr[1])); }
    const bool keep = __all(pmax - m_reg <= THR / SCALE);
    mn = keep ? m_reg : fmaxf(m_reg, pmax); alpha = __builtin_amdgcn_exp2f((m_reg - mn) * C); m_reg = mn;
    SGB4(4); }
  { PV_BLOCK_READS(2)
    PV_BLOCK_MMA(2)
    const float mnC = -mn * C;
#pragma unroll
    for (int r = 0; r < 16; ++r) p0[r] = fmaf(p0[r], C, mnC);
#pragma unroll
    for (int r = 0; r < 16; ++r) p1[r] = fmaf(p1[r], C, mnC);
    SGB4(8); }
  { PV_BLOCK_READS(3)
    PV_BLOCK_MMA(3)
#pragma unroll
    for (int r = 0; r < 16; ++r) p0[r] = __builtin_amdgcn_exp2f(p0[r]);
    SGB4(4); }
}
#undef SGB4
#undef PV_BLOCK_READS
#undef PV_BLOCK_MMA
#undef PKV
__device__ __forceinline__ void pv_d0(f32x16* o, int vb, bf16x8 pa0, bf16x8 pa1, bf16x8 pa2, bf16x8 pa3) {
  pv_one<0>(o[0], vb, pa0, pa1, pa2, pa3); pv_one<1>(o[1], vb, pa0, pa1, pa2, pa3); pv_one<2>(o[2], vb, pa0, pa1, pa2, pa3); pv_one<3>(o[3], vb, pa0, pa1, pa2, pa3);
}
template <int LDQ, int LDK, int LDO>
__device__ __forceinline__ void attn_dense_body(const bf16_t* __restrict__ Qb, const bf16_t* __restrict__ Kh, const bf16_t* __restrict__ Vh,
                                                bf16_t* __restrict__ Ob, int seq, char* lds, const float* __restrict__ ssq, const int tid) {
  const int wid = tid >> 6, lane = tid & 63, r32 = lane & 31, hi = lane >> 5;
  bf16_t* V_lds = (bf16_t*)lds; bf16_t* K_lds = (bf16_t*)(lds + 2 * SHM_V);
  float* ws = (float*)(lds + 2 * SHM_V + 2 * SHM_K) + wid * 64; float* li_l = ws; float* al_l = ws + 32;
  float m_reg = -1e30f, l_reg = 0; f32x16 o[4] = {}; bf16x8 qr[8];
  const bf16_t* Qw = Qb + (long)(wid * QBLK + r32) * LDQ + hi * 8;
  const float rq = __builtin_amdgcn_rsqf(ssq[(wid * QBLK + r32) * 16] * (1.f / 128.f) + EPS);
#pragma unroll
  for (int d0 = 0; d0 < 8; ++d0) { const u32x4 w = *reinterpret_cast<const u32x4*>(Qw + d0 * 16); f32x4 lo, hi2; pg8::unpack8(w, lo, hi2);
    const u32x4 o = pg8::pack8(lo * rq, hi2 * rq); qr[d0] = *reinterpret_cast<const bf16x8*>(&o); }
  const int sr = tid >> 4, sc = (tid & 15) * 8, vst0 = v_st(sr, sc), vst1 = v_st(32 + sr, sc);
  const int vb0 = (int)(uintptr_t)V_lds + v_rd_base(lane);
  struct { bf16x8 vs0, vs1, ks0, ks1; } sr_[2];
#define SLOAD(i, k0) do { sr_[i].vs0 = *reinterpret_cast<const bf16x8*>(&Vh[(long)((k0) + sr) * LDK + sc]); sr_[i].vs1 = *reinterpret_cast<const bf16x8*>(&Vh[(long)((k0) + 32 + sr) * LDK + sc]); \
    sr_[i].ks0 = *reinterpret_cast<const bf16x8*>(&Kh[(long)((k0) + sr) * LDK + sc]); sr_[i].ks1 = *reinterpret_cast<const bf16x8*>(&Kh[(long)((k0) + 32 + sr) * LDK + sc]); } while (0)
#define SWRITE(b, i) do { *(bf16x8*)((char*)V_lds + (b) * SHM_V + vst0) = sr_[i].vs0;          \
    *(bf16x8*)((char*)V_lds + (b) * SHM_V + vst1) = sr_[i].vs1; int kc = sc * 2;               \
    *(bf16x8*)((char*)K_lds + (b) * SHM_K + KSWZ(sr, kc)) = sr_[i].ks0;                       \
    *(bf16x8*)((char*)K_lds + (b) * SHM_K + KSWZ(32 + sr, kc)) = sr_[i].ks1; } while (0)
#define SWAIT() asm volatile("s_waitcnt vmcnt(4)" ::: "memory")
#define RESC(a) do { if (__any((a) < 1.f)) { if (hi == 0) al_l[r32] = (a); asm volatile("s_waitcnt lgkmcnt(0)" ::: "memory"); \
    _Pragma("unroll") for (int d = 0; d < 4; ++d) _Pragma("unroll") for (int r = 0; r < 16; ++r) o[d][r] *= al_l[crow(r, hi)]; } } while (0)
  f32x16 pA0, pA1, pB0, pB1; float mnA, mnB, alA, alB; bf16x8 pa0, pa1, pa2, pa3; const int NT = seq / KVBLK;
  constexpr int SE = 0, SO = 1;
  SLOAD(SE, 0); asm volatile("s_waitcnt vmcnt(0)" ::: "memory"); SWRITE(0, SE); __syncthreads();
  qkt(pA0, pA1, K_lds, qr, r32, hi); partialSM(pA0, pA1, m_reg, mnA, alA);
  SLOAD(SO, KVBLK); if (2 < NT) SLOAD(SE, 2 * KVBLK);
  SWAIT(); SWRITE(1, SO); __syncthreads();
  for (int j = 1; j + 1 < NT; j += 2) {
    SBAR(); qkt(pB0, pB1, (bf16_t*)((char*)K_lds + SHM_K), qr, r32, hi);
    finishSM(pA0, pA1, alA, l_reg, pa0, pa1, pa2, pa3); SBAR();
    SLOAD(SO, (j + 2) * KVBLK); SBAR();
    pv_sm(o, vb0, pa0, pa1, pa2, pa3, pB0, pB1, m_reg, mnB, alB);
    __syncthreads(); SWAIT(); SWRITE(0, SE);
    RESC(alB); __syncthreads();
    SBAR(); qkt(pA0, pA1, K_lds, qr, r32, hi);
    finishSM(pB0, pB1, alB, l_reg, pa0, pa1, pa2, pa3); SBAR();
    if (j + 3 < NT) SLOAD(SE, (j + 3) * KVBLK); SBAR();
    pv_sm(o, vb0 + (int)SHM_V, pa0, pa1, pa2, pa3, pA0, pA1, m_reg, mnA, alA);
    __syncthreads(); SWAIT(); SWRITE(1, SO);
    RESC(alA); __syncthreads();
  }
  SBAR(); qkt(pB0, pB1, (bf16_t*)((char*)K_lds + SHM_K), qr, r32, hi);
  finishSM(pA0, pA1, alA, l_reg, pa0, pa1, pa2, pa3); SBAR();
  pv_sm(o, vb0, pa0, pa1, pa2, pa3, pB0, pB1, m_reg, mnB, alB);
  __syncthreads(); RESC(alB);
  finishSM(pB0, pB1, alB, l_reg, pa0, pa1, pa2, pa3); SBAR();
  pv_d0(o, vb0 + (int)SHM_V, pa0, pa1, pa2, pa3);
  if (hi == 0) li_l[r32] = l_reg; asm volatile("s_waitcnt lgkmcnt(0)" ::: "memory");
  float rli[16];
#pragma unroll
  for (int r = 0; r < 16; ++r) rli[r] = __builtin_amdgcn_rcpf(li_l[crow(r, hi)]);
  bf16_t* Ow = Ob + (long)(wid * QBLK) * LDO;
#pragma unroll
  for (int r = 0; r < 16; ++r) { int orow = crow(r, hi);
#pragma unroll
    for (int d0 = 0; d0 < 4; ++d0) Ow[(long)orow * LDO + d0 * 32 + r32] = (bf16_t)(cvt_pk_bf16(o[d0][r] * rli[r], 0.f) & 0xffffu); }
  __syncthreads();
#undef SLOAD
#undef SWRITE
#undef SWAIT
#undef RESC
}
}

__device__ __forceinline__ void transpose_item(const float* __restrict__ W, int N, bf16_t* __restrict__ WT, int ldt, int koff, LAS float* scr, int kb, int nb, int lane, int nperm) {
    const int k0 = 64 * kb, n0 = 64 * nb, lr = lane >> 4, lc = (lane & 15) * 4;
    const float* p = W + (size_t)(k0 + lr) * N + n0 + lc; const size_t step = (size_t)4 * N;
    f32x4 v[16];
#pragma unroll
    for (int i = 0; i < 16; ++i) { v[i] = *(const f32x4*)p; p += step; }
#pragma unroll
    for (int i = 0; i < 16; ++i) { LAS float* d = scr + (4 * i + lr) * 65 + lc; d[0] = v[i][0]; d[1] = v[i][1]; d[2] = v[i][2]; d[3] = v[i][3]; }
    asm volatile("s_waitcnt lgkmcnt(0)" ::: "memory");
    const int c = lane & 7;
#pragma unroll
    for (int j = 0; j < 8; ++j) { const int n = (lane >> 3) + 8 * j; const LAS float* s = scr + (8 * c) * 65 + n;
        u32x4 o; o.x = cvt_pk_bf16(s[0 * 65], s[1 * 65]); o.y = cvt_pk_bf16(s[2 * 65], s[3 * 65]); o.z = cvt_pk_bf16(s[4 * 65], s[5 * 65]); o.w = cvt_pk_bf16(s[6 * 65], s[7 * 65]);
        const int dn = (n0 < nperm) ? n0 + 8 * ((n & 31) >> 2) + 4 * (n >> 5) + (n & 3) : n0 + n;
        *(u32x4*)(WT + (size_t)dn * ldt + koff + k0 + 8 * c) = o; }
    asm volatile("s_waitcnt lgkmcnt(0)" ::: "memory");
}
__device__ __forceinline__ void rms_row_to_bf16(const float* __restrict__ xrow, const float* __restrict__ g, bf16_t* __restrict__ orow, int lane) {
    const f32x4* xr = (const f32x4*)xrow + lane; const f32x4* gr = (const f32x4*)g + lane;
    f32x4 v[8]; float s = 0.f;
#pragma unroll
    for (int j = 0; j < 8; ++j) { v[j] = xr[64 * j]; s += (v[j][0] * v[j][0] + v[j][1] * v[j][1]) + (v[j][2] * v[j][2] + v[j][3] * v[j][3]); }
    const float r = __builtin_amdgcn_rsqf(wave_sum(s) * (1.f / DM) + EPS);
    u32x2* o8 = (u32x2*)orow + lane;
#pragma unroll
    for (int j = 0; j < 8; ++j) { const f32x4 gg = gr[64 * j]; u32x2 w; w.x = cvt_pk_bf16(v[j][0] * r * gg[0], v[j][1] * r * gg[1]); w.y = cvt_pk_bf16(v[j][2] * r * gg[2], v[j][3] * r * gg[3]); o8[64 * j] = w; }
}
__device__ __forceinline__ void sincos_pos(float af, float& s, float& c) {
    const double a = (double)af;
    const double n = __builtin_rint(a * 0.63661977236758134308);
    const double r = __builtin_fma(-n, 1.57079632679489661923, a) - n * 6.12323399573676603587e-17;
    const double r2 = r * r;
    double ps = -2.5052108385441718775e-08; ps = ps * r2 + 2.7557319223985890653e-06; ps = ps * r2 - 1.9841269841269841270e-04; ps = ps * r2 + 8.3333333333333333333e-03; ps = ps * r2 - 1.6666666666666666667e-01;
    const double sr = r + r * r2 * ps;
    double pc = 2.0876756987868098979e-09; pc = pc * r2 - 2.7557319223985890653e-07; pc = pc * r2 + 2.4801587301587301587e-05; pc = pc * r2 - 1.3888888888888888889e-03; pc = pc * r2 + 4.1666666666666666667e-02; pc = pc * r2 - 0.5;
    const double cr = 1.0 + r2 * pc;
    const int q = ((int)n) & 3;
    const double ss = (q & 1) ? cr : sr, cc = (q & 1) ? sr : cr;
    s = (float)((q & 2) ? -ss : ss); c = (float)(((q + 1) & 2) ? -cc : cc);
}

constexpr int I_IN = (DM / 64) * (INW / 64), I_MKV = (DM / 64) * (1024 / 64), I_AO = (1024 / 64) * (DM / 64), I_GO = (512 / 64) * (DM / 64), I_MO = I_GO,
              I_OUT = (DM / 64) * (DM / 64), I_UP = (DM / 64) * (DFF / 64), I_DN = (DFF / 64) * (DM / 64);
constexpr int IT_EARLY = I_IN + I_MKV, NITEMS = IT_EARLY + I_AO + I_GO + I_MO + I_OUT + I_UP + I_DN, IT_P0 = IT_EARLY;

#define XB_TMO      128
#define XB_XCNT(j)  (256  + 64 * (j))
#define XB_XSUB(j)  (1280 + 64 * (j))
#define XB_XGEN(j)  (2304 + 64 * (j))
#define XB_TOP      3328
#define XB_TOPGEN   3392
#define XCD_BAR_WORDS 3456
#define XB_SPIN_CAP (1u << 18)
__device__ __forceinline__ unsigned xb_ld(unsigned* p)              { return __hip_atomic_load(p, __ATOMIC_RELAXED, __HIP_MEMORY_SCOPE_AGENT); }
__device__ __forceinline__ unsigned xb_add(unsigned* p, unsigned v) { return __hip_atomic_fetch_add(p, v, __ATOMIC_RELAXED, __HIP_MEMORY_SCOPE_AGENT); }
__device__ __forceinline__ unsigned xb_xcc_id() { return (unsigned)__builtin_amdgcn_s_getreg((3 << 11) | 20) & 0xFu; }
#define XB_SPIN(cond, bar) do { unsigned _sp = 0; while (cond) { __builtin_amdgcn_s_sleep(1); \
    if ((++_sp & 255u) == 0u) { if (xb_ld(&(bar)[XB_TMO])) break; if (_sp > XB_SPIN_CAP) { atomicAdd(&(bar)[XB_TMO], 1u); break; } } } } while (0)
struct XcdBarrier { unsigned* bar; unsigned x; volatile LAS unsigned* st; };
__device__ __forceinline__ XcdBarrier xcd_barrier_post(unsigned* bar, volatile LAS unsigned* st) {
    XcdBarrier b; b.bar = bar; b.x = xb_xcc_id(); b.st = st;
    if (threadIdx.x == 0) (void)xb_add(&bar[XB_XCNT(b.x)], 1u);
    return b;
}
__device__ __forceinline__ void xcd_barrier_complete(unsigned* bar, unsigned x, unsigned& nloc, unsigned& nx) {
    const unsigned G = gridDim.x * gridDim.y * gridDim.z;
    unsigned sum, cnt, mine, sp = 0u;
    for (;;) {
        sum = 0u; cnt = 0u; mine = 0u;
#pragma unroll
        for (unsigned j = 0; j < 16; ++j) { const unsigned c = xb_ld(&bar[XB_XCNT(j)]); sum += c; cnt += (c > 0u) ? 1u : 0u; mine = (j == x) ? c : mine; }
        if (sum == G) break;
        __builtin_amdgcn_s_sleep(1);
        if ((++sp & 255u) == 0u) { if (xb_ld(&bar[XB_TMO])) break; if (sp > XB_SPIN_CAP) { atomicAdd(&bar[XB_TMO], 1u); break; } }
    }
    nloc = mine > 0u ? mine : 1u; nx = cnt > 0u ? cnt : 1u;
}
__device__ __forceinline__ void xcd_barrier(const XcdBarrier& b, const int wave) {
    asm volatile("s_waitcnt vmcnt(0)" ::: "memory");
    __syncthreads();
    if (wave == 0 && __builtin_amdgcn_mbcnt_lo(~0u, 0u) == 0u) {
        unsigned* bar = b.bar;
        __builtin_amdgcn_s_waitcnt(0);
        unsigned nloc = b.st[0], nx = b.st[1];
        if (nloc == 0u) { xcd_barrier_complete(bar, b.x, nloc, nx); b.st[0] = nloc; b.st[1] = nx; }
        const unsigned old = xb_add(&bar[XB_XSUB(b.x)], 1u);
        const unsigned gen = old / nloc;
        if (old + 1u == (gen + 1u) * nloc) {
            __builtin_amdgcn_fence(__ATOMIC_RELEASE, "agent");
            asm volatile("s_waitcnt vmcnt(0)" ::: "memory");
            const unsigned og = xb_add(&bar[XB_TOP], 1u);
            const unsigned tg = og / nx;
            if (og + 1u == (tg + 1u) * nx) xb_add(&bar[XB_TOPGEN], 1u);
            else XB_SPIN(xb_ld(&bar[XB_TOPGEN]) == tg, bar);
            __builtin_amdgcn_fence(__ATOMIC_ACQUIRE, "agent");
            xb_add(&bar[XB_XGEN(b.x)], 1u);
            asm volatile("s_waitcnt vmcnt(0)" ::: "memory");
        } else {
            XB_SPIN(xb_ld(&bar[XB_XGEN(b.x)]) == gen, bar);
            __builtin_amdgcn_fence(__ATOMIC_ACQUIRE, "agent");
            asm volatile("s_waitcnt vmcnt(0)" ::: "memory");
        }
    }
    __syncthreads();
}

__global__ void __launch_bounds__(512, 1) fwd_megakernel(Args a_unused) {
    extern __shared__ __attribute__((aligned(16))) unsigned char lds_raw[];
    LAS unsigned char* lds = (LAS unsigned char*)lds_raw;
    const int tid0 = threadIdx.x, wave = __builtin_amdgcn_readfirstlane(tid0 >> 6);
    const int G = gridDim.x, bx = blockIdx.x;
    const int gw = bx * 8 + wave, NGW = G * 8;
#define a (*ap)
#define PHASE_ENTER() int tid_; asm volatile("v_mbcnt_lo_u32_b32 %0, -1, 0\n\tv_mbcnt_hi_u32_b32 %0, -1, %0\n\tv_lshl_add_u32 %0, %1, 6, %0" : "=&v"(tid_) : "s"(wave));   \
    const int tid = tid_ & 511, lane = tid & 63; (void)lane; \
    CArgs* ap = ARGP(); unsigned char* ws = a.ws; \
    bf16_t* WdownT = (bf16_t*)(ws + WS_WDOWN); bf16_t* WupT = (bf16_t*)(ws + WS_WUP); bf16_t* WoutT = (bf16_t*)(ws + WS_WOUT); bf16_t* WcatT = (bf16_t*)(ws + WS_WCAT); \
    bf16_t* Hb = (bf16_t*)(ws + WS_H); bf16_t* XCAT = Hb; bf16_t* A2 = Hb; \
    float* SSVP = (float*)(ws + WS_SMALL + SM_SSVP); float* SSQ = (float*)(ws + WS_SMALL + SM_SSQ); float* CS = (float*)(ws + WS_SMALL + SM_CS); bf16_t* MEMN = (bf16_t*)(ws + WS_SMALL + SM_MEMN); \
    bf16_t* KMb = (bf16_t*)(ws + WS_SMALL + SM_KMB); bf16_t* VMb = (bf16_t*)(ws + WS_SMALL + SM_VMB); \
    bf16_t* WinT = (bf16_t*)(ws + WS_R0); bf16_t* Qb = (bf16_t*)((unsigned char*)a.out + R0_QB); bf16_t* Kb = (bf16_t*)((unsigned char*)a.out + R0_KB); bf16_t* GVb = (bf16_t*)((unsigned char*)a.out + R0_VN); \
    bf16_t* MERGED = (bf16_t*)(ws + WS_R0); bf16_t* U2 = (bf16_t*)(ws + WS_R0); \
    bf16_t* WmkvT = (bf16_t*)(ws + WS_WMKV); bf16_t* GATES = (bf16_t*)(ws + WS_GATES); \
    bf16_t* Vb = (bf16_t*)(ws + WS_VB); bf16_t* Ub = (bf16_t*)(ws + WS_UB); \
    LAS float* xch = (LAS float*)(lds + LDS_XCH_OFF);
    const int lo = ((CArgs*)__builtin_amdgcn_kernarg_segment_ptr())->ph_lo, hi = ((CArgs*)__builtin_amdgcn_kernarg_segment_ptr())->ph_hi;
#ifndef PHASE_MASK
#define PHASE_MASK 0xff
#endif
#define IN(k) (((PHASE_MASK >> (k)) & 1) && lo <= (k) && (k) < hi)
    volatile LAS unsigned* xb_st = (volatile LAS unsigned*)(lds + LDS_ST_OFF);
    if (tid0 == 0) { xb_st[0] = 0u; xb_st[1] = 0u; }
    __syncthreads();
    const XcdBarrier xbar = xcd_barrier_post((unsigned*)(((CArgs*)__builtin_amdgcn_kernarg_segment_ptr())->ws + WS_SMALL + SM_BAR), xb_st);
#define SYNC(k) do { if (IN(k)) xcd_barrier(xbar, wave); } while (0)

    if (IN(0)) { PHASE_ENTER();
        for (int i = bx * 512 + tid; i < S * 4; i += G * 512) ((f32x4*)SSQ)[i] = (f32x4){127.999872f, 127.999872f, 127.999872f, 127.999872f};
        for (int i = bx * 512 + tid; i < 128 * 32; i += G * 512) {
            const int pos = i >> 5, f = i & 31; float sn, cs; sincos_pos((float)pos * __builtin_amdgcn_exp2f((float)f * (-13.287712379549449f / 32.0f)), sn, cs);
            CS[2 * i] = cs; CS[2 * i + 1] = sn; }
        LAS float* scr = (LAS float*)(lds + wave * 16640);
#define TRANSPOSE_ITEMS(IT0, IT1, W0, NW_) \
        for (int it = (IT0) + (W0); it < (IT1); it += (NW_)) { \
            int r = it; const float* W; bf16_t* WT; int N, ldt, koff, nperm = 0; \
            if (r < I_IN) { W = a.w_in; N = INW; WT = WinT; ldt = DM; koff = 0; nperm = 1280; } \
            else if ((r -= I_IN) < I_MKV) { W = a.w_mem_kv; N = 1024; WT = WmkvT; ldt = DM; koff = 0; } \
            else if ((r -= I_MKV) < I_AO) { W = a.w_attn_o; N = DM; WT = WcatT; ldt = DM; koff = 0; } \
            else if ((r -= I_AO) < I_GO) { W = a.w_gmlp_o; N = DM; WT = WcatT; ldt = DM; koff = 1024; } \
            else if ((r -= I_GO) < I_MO) { W = a.w_mem_o; N = DM; WT = WcatT; ldt = DM; koff = 1536; } \
            else if ((r -= I_MO) < I_OUT) { W = a.w_out; N = DM; WT = WoutT; ldt = DM; koff = 0; } \
            else if ((r -= I_OUT) < I_UP) { W = a.w_ffn_up; N = DFF; WT = WupT; ldt = DM; koff = 0; } \
            else { r -= I_UP; W = a.w_ffn_down; N = DM; WT = WdownT; ldt = DFF; koff = 0; } \
              \
            const int nbk = N >> 6, g8 = 8 * nbk, kb8 = r / g8, rem = r - kb8 * g8; \
            transpose_item(W, N, WT, ldt, koff, scr, kb8 * 8 + (rem & 7), rem >> 3, lane, nperm); \
        }
        TRANSPOSE_ITEMS(0, IT_P0, gw, NGW)
        for (int m = gw; m < S + MEMT; m += NGW) {
            if (m < S) rms_row_to_bf16(a.x + (size_t)m * DM, a.norm_mix, Hb + (size_t)m * DM, lane);
            else rms_row_to_bf16(a.mem + (size_t)(m - S) * DM, a.mem_norm, MEMN + (size_t)(m - S) * DM, lane);
        }
        __syncthreads();
    }
    SYNC(0);

    if (IN(1)) { PHASE_ENTER();
        { pg8::Gemm g{Hb, WinT, DM}; pg8::InProjOrder So; So.init(S, INW, DM, G, bx);
          pg8::EpiInProj E{xch};
          pg8::gemm_phase(lds, g, So, E, tid); }
        { pg8::Gemm g{MEMN, WmkvT, DM}; pg8::StaticOrder So; So.init(MEMT, 1024, DM, G, (bx + G / 2) % G);
          pg8::EpiMemKV E{xch};
          pg8::gemm_phase(lds, g, So, E, tid); }
        if (bx >= G / 2 + 4) {
            LAS float* scr = (LAS float*)(lds + wave * 16640);
            TRANSPOSE_ITEMS(IT_P0, NITEMS, (bx - G / 2 - 4) * 8 + wave, (G - G / 2 - 4) * 8)
            __syncthreads();
        }
    }
    SYNC(1);


    if (IN(3)) { PHASE_ENTER();
#ifndef P3_MASK
#define P3_MASK 7
#endif
        if (P3_MASK & 1) for (int w = bx; w < 384; w += G) {
            const bool self = w < 256; const int h = self ? (w & 7) : (w & 3), qb = self ? (w >> 3) : ((w - 256) >> 2);
            const bf16_t* Qp = Qb + (size_t)qb * 256 * 1536 + (self ? h * 128 : 1024 + h * 128);
            const bf16_t* Kp = self ? Kb + (h >> 2) * 128 : KMb + (size_t)(h >> 1) * 65536 + (h & 1) * 128;
            const bf16_t* Vp = self ? Vb + (h >> 2) * 128 : VMb + (size_t)(h >> 1) * 65536 + (h & 1) * 128;
            bf16_t* Op = XCAT + (size_t)qb * 256 * 2048 + (self ? h * 128 : 1536 + h * 128);
            att::attn_dense_body<1536, 256, 2048>(Qp, Kp, Vp, Op, self ? S : MEMT, (char*)lds_raw, SSQ + (size_t)qb * 256 * 16 + (self ? h : 8 + h), tid);
        }
        if ((P3_MASK & 4) && bx >= G / 2) for (int w = bx - G / 2; w < 256; w += G - G / 2) {
            const int c = w >> 2, g = w & 3; LAS bf16_t* vt = (LAS bf16_t*)lds; constexpr int PITCH = 144;
            const int fr = lane & 15, fq = lane >> 4, i0 = wave * 16;
            {
                u32x4 vst[4];
#pragma unroll
                for (int q = 0; q < 4; ++q) { const int ch = tid + q * 512, jr = ch >> 4, dc = (ch & 15) * 8; vst[q] = *(const u32x4*)(GVb + (size_t)(c * 128 + jr) * 512 + g * 128 + dc); }
                const float* wsr = a.w_spatial + (size_t)g * 128 * 128 + (size_t)(i0 + fr) * 128 + fq * 8;
                f32x4 wv[4][2], sv[4][2];
#pragma unroll
                for (int ks = 0; ks < 4; ++ks) { wv[ks][0] = *(const f32x4*)(wsr + ks * 32); wv[ks][1] = *(const f32x4*)(wsr + ks * 32 + 4);
                    const float* sp = SSVP + ((size_t)c * 128 + ks * 32 + fq * 8) * 2; const f32x4 p0 = *(const f32x4*)sp, p1 = *(const f32x4*)(sp + 4), p2 = *(const f32x4*)(sp + 8), p3 = *(const f32x4*)(sp + 12);
                    sv[ks][0] = (f32x4){p0[0] + p0[1], p0[2] + p0[3], p1[0] + p1[1], p1[2] + p1[3]}; sv[ks][1] = (f32x4){p2[0] + p2[1], p2[2] + p2[3], p3[0] + p3[1], p3[2] + p3[3]}; }
                const size_t t = (size_t)c * 128 + i0 + fr;
                const float bs = a.b_spatial[g * 128 + i0 + fr];
                u32x2 ubv[8]; f32x4 sg[8];
#pragma unroll
                for (int n = 0; n < 8; ++n) { ubv[n] = *(const u32x2*)(Ub + t * 512 + g * 128 + n * 16 + fq * 4); sg[n] = *(const f32x4*)(a.sgu_norm + g * 128 + n * 16 + fq * 4); }
#pragma unroll
                for (int q = 0; q < 4; ++q) { const int ch = tid + q * 512, jr = ch >> 4, dc = (ch & 15) * 8; LAS bf16_t* p = vt + dc * PITCH + jr;
                    p[0 * PITCH] = (bf16_t)(vst[q].x & 0xffffu); p[1 * PITCH] = (bf16_t)(vst[q].x >> 16); p[2 * PITCH] = (bf16_t)(vst[q].y & 0xffffu); p[3 * PITCH] = (bf16_t)(vst[q].y >> 16);
                    p[4 * PITCH] = (bf16_t)(vst[q].z & 0xffffu); p[5 * PITCH] = (bf16_t)(vst[q].z >> 16); p[6 * PITCH] = (bf16_t)(vst[q].w & 0xffffu); p[7 * PITCH] = (bf16_t)(vst[q].w >> 16); }
                __syncthreads();
                f32x4 acc[8];
#pragma unroll
                for (int n = 0; n < 8; ++n) acc[n] = (f32x4){0.f, 0.f, 0.f, 0.f};
#pragma unroll
                for (int ks = 0; ks < 4; ++ks) {
                    f32x4 w0 = wv[ks][0], w1 = wv[ks][1];
#pragma unroll
                    for (int e = 0; e < 4; ++e) { w0[e] *= __builtin_amdgcn_rsqf(sv[ks][0][e] * (1.f / 512.f) + EPS); w1[e] *= __builtin_amdgcn_rsqf(sv[ks][1][e] * (1.f / 512.f) + EPS); }
                    const u32x4 aw = pg8::pack8(w0, w1); const bf16x8 wf = *reinterpret_cast<const bf16x8*>(&aw);
#pragma unroll
                    for (int n = 0; n < 8; ++n) { const bf16x8 vf = *(const LAS bf16x8*)(vt + (n * 16 + fr) * PITCH + ks * 32 + fq * 8);
                        acc[n] = __builtin_amdgcn_mfma_f32_16x16x32_bf16(vf, wf, acc[n], 0, 0, 0); }
                }
#pragma unroll
                for (int n = 0; n < 8; ++n) { f32x4 o;
                    o[0] = __uint_as_float(ubv[n].x << 16) * (acc[n][0] * sg[n][0] + bs); o[1] = __uint_as_float(ubv[n].x & 0xffff0000u) * (acc[n][1] * sg[n][1] + bs);
                    o[2] = __uint_as_float(ubv[n].y << 16) * (acc[n][2] * sg[n][2] + bs); o[3] = __uint_as_float(ubv[n].y & 0xffff0000u) * (acc[n][3] * sg[n][3] + bs);
                    *(u32x2*)(XCAT + t * 2048 + 1024 + g * 128 + n * 16 + fq * 4) = pg8::pack4(o); }
                __syncthreads();
            }
        }
    }
    SYNC(3);

    if (IN(4)) { PHASE_ENTER();
        pg8::Gemm g{XCAT, WcatT, DM}; pg8::BranchOrder So; So.init(S, DM, G, bx);
        pg8::EpiBranch E{};
        pg8::gemm_phase(lds, g, So, E, tid);
    }
    SYNC(4);

    if (IN(5)) { PHASE_ENTER();
        pg8::Gemm g{MERGED, WoutT, DM}; pg8::StaticOrder So; So.init(S, DM, DM, G, bx);
        pg8::EpiOut E{xch};
        pg8::gemm_phase(lds, g, So, E, tid, pg8::ResidInit{0});
    }
    SYNC(5);

    if (IN(6)) { PHASE_ENTER();
        pg8::Gemm g{A2, WupT, DM}; pg8::StaticOrder So; So.init(S, DFF, DM, G, bx);
        pg8::EpiUp E; { pg8::Unit u0; E.pm0 = So.next(0, u0) ? u0.pm : -1;
            const int wid_ = tid >> 6; pg8::EpiUp::load_rs((const float*)(ws + WS_SMALL + SM_ROWSSP), (E.pm0 < 0 ? 0 : E.pm0) * 256 + (wid_ >> 2) * 64 + (lane & 15), E.rs0); }
        pg8::gemm_phase(lds, g, So, E, tid);
    }
    SYNC(6);

    if (IN(7)) { PHASE_ENTER();
        pg8::Gemm g{U2, WdownT, DFF}; pg8::StaticOrder So; So.init(S, DM, DFF, G, bx);
        pg8::EpiDown E{};
        pg8::gemm_phase(lds, g, So, E, tid, pg8::ResidInit{1});
    }
#undef IN
#undef SYNC
#undef a
}

extern "C" void kernel_launch(void* const* d_in, const int* in_sizes, int n_in, void* d_out, int out_size, void* d_ws, size_t ws_size, hipStream_t stream) {
    static int grid = 0;
    if (grid == 0) {
        if (n_in != 20 || in_sizes[0] != S * DM || out_size != S * DM || ws_size < WS_END) {
            fprintf(stderr, "kernel_launch: unexpected shapes: n_in %d in0 %d out %d ws %zu (need %zu)\n", n_in, n_in > 0 ? in_sizes[0] : -1, out_size, ws_size, (size_t)WS_END); grid = -1; return; }
        int dev = 0, cus = 0, per_cu = 0;
        hipGetDevice(&dev); hipDeviceGetAttribute(&cus, hipDeviceAttributeMultiprocessorCount, dev);
        if (hipFuncSetAttribute((const void*)fwd_megakernel, hipFuncAttributeMaxDynamicSharedMemorySize, LDS_BYTES) != hipSuccess) { fprintf(stderr, "kernel_launch: hipFuncSetAttribute failed\n"); grid = -1; return; }
        if (hipOccupancyMaxActiveBlocksPerMultiprocessor(&per_cu, (const void*)fwd_megakernel, 512, LDS_BYTES) != hipSuccess || per_cu < 1) { fprintf(stderr, "kernel_launch: occupancy query failed (%d)\n", per_cu); grid = -1; return; }
        grid = cus;
        fprintf(stderr, "kernel_launch: cus %d per_cu %d grid %d\n", cus, per_cu, grid);
    }
    if (grid < 0) return;
    Args a{};
    const float** f = (const float**)&a;
    for (int i = 0; i < 20; ++i) f[i] = (const float*)d_in[i];
    a.out = (float*)d_out; a.ws = (unsigned char*)d_ws;
#ifndef PROBE_A
#define PROBE_A 8
#define PROBE_B 8
#endif
    hipError_t e = hipSuccess;
    for (int li = 0; li < (PROBE_A < 8 || PROBE_B < 8 ? 2 : 1); ++li) {
        a.ph_lo = li == 0 ? 0 : PROBE_B; a.ph_hi = li == 0 ? PROBE_A : 8;
        if (hipMemsetAsync((char*)d_ws + WS_SMALL + SM_BAR, 0, XCD_BAR_WORDS * 4, stream) != hipSuccess) { fprintf(stderr, "kernel_launch: memset failed\n"); return; }
        void* args[] = {&a};
        e = hipLaunchCooperativeKernel((const void*)fwd_megakernel, dim3(grid), dim3(512), args, LDS_BYTES, stream);
        if (e != hipSuccess) break;
    }
    if (e != hipSuccess) fprintf(stderr, "kernel_launch: cooperative launch failed: %s (grid %d)\n", hipGetErrorString(e), grid);
}
```
